# Optimizing an MI355X kernel written in HIP

```python
import math
import jax, jax.numpy as jnp
from jax import lax
import numpy as np

D_MODEL = 1024
BATCH = 16
SEQ = 4096
DEPTH = 4
DEC_BATCH = 4
DEC_SEQ = 4096
PAST_LEN = 128

HEAD_DIM = 64
A_HEADS = 8
B_HEADS = 8
B_KV_HEADS = 2
A_WIDTH = A_HEADS * HEAD_DIM
B_WIDTH = B_HEADS * HEAD_DIM
B_KV_WIDTH = B_KV_HEADS * HEAD_DIM
MIX_WIDTH = A_WIDTH + B_WIDTH
ATTN_IN = 3 * A_WIDTH + B_WIDTH + 2 * B_KV_WIDTH + MIX_WIDTH
DILATED_PATTERNS = ((128, 1), (512, 4), (2048, 16))
ROPE_THETA = 500000.0
ROPE_DIM = HEAD_DIM // 4
AXIAL_THETA = 10000.0
GRID_W = 64
Q_BLOCK = 128
POOL_WINDOWS = (2, 4, 8, 16)
POOL_GROUPS = 4
POOL_WIDTH = D_MODEL
POOL_GROUP_DIM = POOL_WIDTH // POOL_GROUPS
NORM_EPS = 1e-6
NEG_INF = -1e30

kernel_name = 'hybrid_dilated_axial_pool_encoder'


def _rmsnorm(x, g):
    x32 = x.astype(jnp.float32)
    y = x32 * lax.rsqrt(jnp.mean(x32 * x32, axis=-1, keepdims=True) + NORM_EPS)
    return (y * g.astype(jnp.float32)).astype(x.dtype)


def _rope(x, pos, theta):
    r = x.shape[-1]
    inv = theta ** (-jnp.arange(0, r, 2, dtype=jnp.float32) / r)
    ang = pos.astype(jnp.float32)[:, None] * inv[None, :]
    cos = jnp.cos(ang)[:, None, :]
    sin = jnp.sin(ang)[:, None, :]
    x32 = x.astype(jnp.float32)
    x1, x2 = x32[..., : r // 2], x32[..., r // 2:]
    return jnp.concatenate([x1 * cos - x2 * sin, x1 * sin + x2 * cos], axis=-1).astype(x.dtype)


def _partial_rope(x, pos):
    return jnp.concatenate([_rope(x[..., :ROPE_DIM], pos, ROPE_THETA), x[..., ROPE_DIM:]], axis=-1)


def _axial_rope(x, row, col):
    half = HEAD_DIM // 2
    return jnp.concatenate([_rope(x[..., :half], row, AXIAL_THETA),
                            _rope(x[..., half:], col, AXIAL_THETA)], axis=-1)


def _banded_attention(q, k, v, radius):
    n, L, h, dh = q.shape
    blk = radius
    nb = -(-L // blk)
    lp = nb * blk
    qp = jnp.pad(q, ((0, 0), (0, lp - L), (0, 0), (0, 0))).reshape(n, nb, blk, h, dh)
    pad_k = ((0, 0), (blk, lp - L + blk), (0, 0), (0, 0))
    kb = jnp.pad(k, pad_k).reshape(n, nb + 2, blk, h, dh)
    vb = jnp.pad(v, pad_k).reshape(n, nb + 2, blk, h, dh)
    kw = jnp.concatenate([kb[:, :-2], kb[:, 1:-1], kb[:, 2:]], axis=2)
    vw = jnp.concatenate([vb[:, :-2], vb[:, 1:-1], vb[:, 2:]], axis=2)
    qpos = jnp.arange(lp).reshape(nb, blk)
    kpos = jnp.arange(nb)[:, None] * blk - blk + jnp.arange(3 * blk)[None, :]
    kp = kpos[:, None, :]
    valid = (jnp.abs(qpos[:, :, None] - kp) <= radius) & (kp >= 0) & (kp < L)
    s = jnp.einsum('nbqhd,nbkhd->nbhqk', qp, kw).astype(jnp.float32) / math.sqrt(dh)
    s = jnp.where(valid[None, :, None], s, NEG_INF)
    lse = jax.nn.logsumexp(s, axis=-1)
    p = jnp.exp(s - lse[..., None])
    o = jnp.einsum('nbhqk,nbkhd->nbqhd', p.astype(v.dtype), vw)
    o = o.reshape(n, lp, h, dh)[:, :L]
    lse = lse.transpose(0, 1, 3, 2).reshape(n, lp, h)[:, :L]
    return o, lse


def _dilated_window_attention(q, k, v):
    b, s, h, dh = q.shape
    outs, lses = [], []
    for window, dil in DILATED_PATTERNS:
        radius = window // (2 * dil)
        L = s // dil

        def to_res(t):
            return t.reshape(b, L, dil, h, dh).swapaxes(1, 2).reshape(b * dil, L, h, dh)

        o, lse = _banded_attention(to_res(q), to_res(k), to_res(v), radius)
        outs.append(o.reshape(b, dil, L, h, dh).swapaxes(1, 2).reshape(b, s, h, dh))
        lses.append(lse.reshape(b, dil, L, h).swapaxes(1, 2).reshape(b, s, h))
    wts = jax.nn.softmax(jnp.stack(lses), axis=0)
    out = jnp.einsum('pbsh,pbshd->bshd', wts, jnp.stack(outs).astype(jnp.float32))
    return out.astype(q.dtype)


def _blocked_gqa(q, k, v):
    b, s, hq, dh = q.shape
    hkv = k.shape[2]
    g = hq // hkv
    nb = s // Q_BLOCK
    qb = q.reshape(b, nb, Q_BLOCK, hkv, g, dh).transpose(1, 0, 2, 3, 4, 5)

    def one_block(qi):
        sc = jnp.einsum('bqhgd,bshd->bhgqs', qi, k).astype(jnp.float32) / math.sqrt(dh)
        p = jax.nn.softmax(sc, axis=-1)
        return jnp.einsum('bhgqs,bshd->bqhgd', p.astype(v.dtype), v)

    o = lax.map(one_block, qb)
    return o.transpose(1, 0, 2, 3, 4, 5).reshape(b, s, hq, dh)


def _attn_mixer(h, w_in, q_norm, k_norm, w_out):
    b, s, _ = h.shape
    proj = h @ w_in
    cuts = [A_WIDTH, 2 * A_WIDTH, 3 * A_WIDTH, 3 * A_WIDTH + B_WIDTH,
            3 * A_WIDTH + B_WIDTH + B_KV_WIDTH, 3 * A_WIDTH + B_WIDTH + 2 * B_KV_WIDTH]
    qa, ka, va, qb, kb, vb, gate = jnp.split(proj, cuts, axis=-1)
    pos = jnp.arange(s)
    qa = _partial_rope(qa.reshape(b, s, A_HEADS, HEAD_DIM), pos)
    ka = _partial_rope(ka.reshape(b, s, A_HEADS, HEAD_DIM), pos)
    va = va.reshape(b, s, A_HEADS, HEAD_DIM)
    oa = _dilated_window_attention(qa, ka, va).reshape(b, s, A_WIDTH)
    rows = s // GRID_W
    row = jnp.repeat(jnp.arange(rows), GRID_W)
    col = jnp.tile(jnp.arange(GRID_W), rows)
    qb = _axial_rope(_rmsnorm(qb.reshape(b, s, B_HEADS, HEAD_DIM), q_norm), row, col)
    kb = _axial_rope(_rmsnorm(kb.reshape(b, s, B_KV_HEADS, HEAD_DIM), k_norm), row, col)
    vb = vb.reshape(b, s, B_KV_HEADS, HEAD_DIM)
    ob = _blocked_gqa(qb, kb, vb).reshape(b, s, B_WIDTH)
    y = jnp.concatenate([oa, ob], axis=-1) * jax.nn.silu(gate)
    return y @ w_out


def _pool_mixer(h, w_in, w_grp, scale, w_out):
    b, s, _ = h.shape
    u, gate = jnp.split(h @ w_in, 2, axis=-1)
    u32 = u.astype(jnp.float32)
    cs = jnp.concatenate([jnp.zeros((b, 1, POOL_WIDTH), jnp.float32), jnp.cumsum(u32, axis=1)], axis=1)
    cs = cs.reshape(b, s + 1, POOL_GROUPS, POOL_GROUP_DIM)
    half = jnp.array(POOL_WINDOWS, dtype=jnp.int32) // 2
    t = jnp.arange(s, dtype=jnp.int32)[:, None]
    lo = jnp.clip(t - half[None, :], 0, s)
    hi = jnp.clip(t + half[None, :], 0, s)
    gidx = jnp.arange(POOL_GROUPS)[None, :]
    win_sum = cs[:, hi, gidx] - cs[:, lo, gidx]
    cnt = (hi - lo).astype(jnp.float32)[None, :, :, None]
    pooled = win_sum / cnt - u32.reshape(b, s, POOL_GROUPS, POOL_GROUP_DIM)
    mixed = jnp.einsum('bsgc,gcd->bsgd', pooled.astype(h.dtype), w_grp)
    mixed = mixed * scale.reshape(POOL_GROUPS, POOL_GROUP_DIM)
    y = mixed.reshape(b, s, POOL_WIDTH) * jax.nn.silu(gate)
    return y @ w_out


def _trunk(x, c, ada_w, ada_b, pre_norm, post_norm, attn_w_in, attn_q_norm, attn_k_norm,
           attn_w_out, pool_w_in, pool_w_grp, pool_scale, pool_w_out):
    for l in range(DEPTH):
        i = l // 2
        mod = jax.nn.silu(c) @ ada_w[l] + ada_b[l]
        shift, scl, gate = jnp.split(mod[:, None, :], 3, axis=-1)
        h = _rmsnorm(x, pre_norm[l]) * (1.0 + scl) + shift
        if l % 2 == 0:
            m = _attn_mixer(h, attn_w_in[i], attn_q_norm[i], attn_k_norm[i], attn_w_out[i])
        else:
            m = _pool_mixer(h, pool_w_in[i], pool_w_grp[i], pool_scale[i], pool_w_out[i])
        x = x + gate * _rmsnorm(m, post_norm[l])
    return x


def setup_inputs(seed: int = 0) -> dict:
    key = jax.random.key(seed)
    ks = jax.random.split(key, 20)
    n_attn = (DEPTH + 1) // 2
    n_pool = DEPTH // 2
    f32 = jnp.float32
    nrm = lambda k, shp: jax.random.normal(k, shp, f32)
    return {
        'x_prompt': nrm(ks[0], (BATCH, SEQ, D_MODEL)),
        'x_sample': nrm(ks[1], (DEC_BATCH, DEC_SEQ, D_MODEL)),
        'c_prompt': nrm(ks[2], (BATCH, D_MODEL)),
        'c_sample': nrm(ks[3], (DEC_BATCH, D_MODEL)),
        'ada_w': nrm(ks[4], (DEPTH, D_MODEL, 3 * D_MODEL)) * (0.3 * D_MODEL ** -0.5),
        'ada_b': nrm(ks[5], (DEPTH, 3 * D_MODEL)) * 0.01,
        'pre_norm': 1.0 + 0.05 * nrm(ks[6], (DEPTH, D_MODEL)),
        'post_norm': 1.0 + 0.05 * nrm(ks[7], (DEPTH, D_MODEL)),
        'attn_w_in': nrm(ks[8], (n_attn, D_MODEL, ATTN_IN)) * D_MODEL ** -0.5,
        'attn_q_norm': 1.0 + 0.05 * nrm(ks[9], (n_attn, HEAD_DIM)),
        'attn_k_norm': 1.0 + 0.05 * nrm(ks[10], (n_attn, HEAD_DIM)),
        'attn_w_out': nrm(ks[11], (n_attn, MIX_WIDTH, D_MODEL)) * MIX_WIDTH ** -0.5,
        'pool_w_in': nrm(ks[12], (n_pool, D_MODEL, 2 * POOL_WIDTH)) * D_MODEL ** -0.5,
        'pool_w_grp': nrm(ks[13], (n_pool, POOL_GROUPS, POOL_GROUP_DIM, POOL_GROUP_DIM)) * POOL_GROUP_DIM ** -0.5,
        'pool_scale': 1.0 + 0.1 * nrm(ks[14], (n_pool, POOL_WIDTH)),
        'pool_w_out': nrm(ks[15], (n_pool, POOL_WIDTH, D_MODEL)) * POOL_WIDTH ** -0.5,
    }


def reference(x_prompt, x_sample, c_prompt, c_sample, ada_w, ada_b, pre_norm, post_norm,
              attn_w_in, attn_q_norm, attn_k_norm, attn_w_out,
              pool_w_in, pool_w_grp, pool_scale, pool_w_out):
    y_prompt = _trunk(x_prompt, c_prompt, ada_w, ada_b, pre_norm, post_norm, attn_w_in, attn_q_norm,
                      attn_k_norm, attn_w_out, pool_w_in, pool_w_grp, pool_scale, pool_w_out)
    y_sample = _trunk(x_sample, c_sample, ada_w, ada_b, pre_norm, post_norm, attn_w_in, attn_q_norm,
                      attn_k_norm, attn_w_out, pool_w_in, pool_w_grp, pool_scale, pool_w_out)
    return (y_prompt, y_sample)
```

```cpp
#ifndef PROBE_DUP
#define PROBE_DUP 0
#endif
#include <hip/hip_cooperative_groups.h>
#include <cmath>
#include <hip/hip_runtime.h>
#include <cstdio>
#include <cstdint>
#define GPTR(T, x) ((T*)(__attribute__((address_space(1))) T*)(x))
struct Args { const float* in[16]; float* out; unsigned char* ws; double invA[8]; double invX[16]; };
typedef const __attribute__((address_space(4))) Args* ArgsP;
__device__ __forceinline__ ArgsP argp() { ArgsP p = (ArgsP)__builtin_amdgcn_kernarg_segment_ptr(); asm volatile("" : "+s"(p)); return p; }
__device__ __forceinline__ const char* uni_ptr(const char* p) { const unsigned long long v = (unsigned long long)p; const unsigned lo = __builtin_amdgcn_readfirstlane((unsigned)v), hi = __builtin_amdgcn_readfirstlane((unsigned)(v >> 32)); return (const char*)(((unsigned long long)hi << 32) | lo); }
namespace pg8 {
#define PG8_LAS __attribute__((address_space(3)))
typedef unsigned short bf16_t;
typedef short bf16x8 __attribute__((ext_vector_type(8)));
typedef float f32x4 __attribute__((ext_vector_type(4)));
typedef unsigned u32x4 __attribute__((ext_vector_type(4)));
constexpr int BM = 256, BK = 64, HALF = 128, HTB = HALF * BK * 2  , STAGE_BYTES = 8 * HTB, NXCD = 8, WGM = 8;

__host__ __device__ __forceinline__ int lds_byte(int r, int c) { const int st = (r >> 4) * 2 + (c >> 5), rr = r & 15, cc = c & 31, ob = rr * 64 + cc * 2; return st * 1024 + (ob ^ (((ob >> 9) & 1) << 5)); }
__host__ __device__ __forceinline__ void stage_rc(int b, int& R, int& C) { const int st = b / 1024, sb = b % 1024, swz = sb ^ (((sb >> 9) & 1) << 5); R = (st >> 1) * 16 + swz / 64; C = (st & 1) * 32 + (swz % 64) / 2; }
__host__ __device__ __forceinline__ int perm32(int rho) { const int n = rho >> 4, i = rho & 15; return 8 * (i >> 2) + 4 * n + (i & 3); }

struct Unit { int pm, pn; };
struct Gemm { const bf16_t* A; const bf16_t* Bt; int M, N, K; int lda; int a_pn_bytes; };

struct StaticOrder {
    int nM, nN, nwg, G, c;
    __host__ __device__ void init(int M, int N, int G_, int c_) { nM = M / BM; nN = N / BM; nwg = nM * nN; G = G_; c = c_; }
    __host__ __device__ bool next(int i, Unit& u) const {
        const long L = (long)i * G + c; if (L >= nwg) return false;
        int wgid = (int)L; { const int q = nwg / NXCD, r = nwg % NXCD, xcd = wgid % NXCD, off = wgid / NXCD; wgid = (xcd < r ? xcd * (q + 1) : r * (q + 1) + (xcd - r) * q) + off; }
        const int nig = WGM * nN, gid = wgid / nig, fm = gid * WGM, gsz = (nM - fm) < WGM ? (nM - fm) : WGM;
        u.pm = fm + ((wgid % nig) % gsz); u.pn = (wgid % nig) / gsz; return true;
    }
    __device__ __forceinline__ void a_ready(const Unit&) const {}
    __device__ __forceinline__ void done(const Unit&) const {}
};

__device__ __forceinline__ unsigned cvt_pk_bf16(float lo, float hi) { unsigned r; asm volatile("v_cvt_pk_bf16_f32 %0, %1, %2" : "=v"(r) : "v"(lo), "v"(hi)); return r; }
typedef float f32x2 __attribute__((ext_vector_type(2)));
constexpr int NSEQ = 20, SEQL = 4096, TOK = NSEQ * SEQL, DM_ = 1024, NPROMPT_TOK = 16 * 4096, ATTN_IN_W = 3328;
constexpr size_t MiB = 1u << 20;
constexpr size_t WS_MOD = 1 * MiB, WS_TAB = 0  , WS_W = 2 * MiB, WS_LSE = 34 * MiB, WS_H = 44 * MiB, WS_SG = 204 * MiB, WS_QA = 364 * MiB, WS_KA = 444 * MiB, WS_VA = 524 * MiB,
                 WS_QB = 604 * MiB, WS_KB = 684 * MiB, WS_VB = 704 * MiB, WS_OA = 724 * MiB, WS_END = 964 * MiB;
constexpr size_t WO_AIN = 0, WO_AOUT = WO_AIN + 2ull * 3328 * 1024, WO_PIN = WO_AOUT + 2ull * 1024 * 1024, WO_GRP = WO_PIN + 2ull * 2048 * 1024, WO_POUT = WO_GRP + 2ull * 4 * 256 * 256, WO_END = WO_POUT + 2ull * 1024 * 1024;
static_assert(WO_END * 2 <= 32 * MiB, "weights region");
constexpr float C2F = 0.125f * 1.4426950408889634f;
struct EpiP { int li; };
struct EpiQ { unsigned char* ws; const float *qnorm, *knorm, *pscale; };
#define EPB(off) ((bf16_t*)(P.ws + (off)))
#define EPF(off) ((const float*)(P.ws + (off)))
__device__ __forceinline__ float silu_f(float x) { return x * __builtin_amdgcn_rcpf(1.f + __expf(-x)); }
__device__ __forceinline__ void st8(bf16_t* p, const float (&v)[8]) { u32x4 w; w.x = cvt_pk_bf16(v[0], v[1]); w.y = cvt_pk_bf16(v[2], v[3]); w.z = cvt_pk_bf16(v[4], v[5]); w.w = cvt_pk_bf16(v[6], v[7]); *(u32x4*)p = w; }
template <int MODE> struct Epi {
    static constexpr bool PERM = true, AFTER_DRAIN = false;
    EpiP P;
    __device__ __forceinline__ void operator()(const f32x4 (&acc)[2][2][4][2], const Unit& u, int wr, int wc, int fr_, int fq_) const {
        int fr = fr_, fq = fq_; asm volatile("" : "+v"(fr), "+v"(fq)); ArgsP ap_ = argp(); const int li_ = this->P.li; EpiQ P{GPTR(unsigned char, ap_->ws), GPTR(const float, ap_->in[9]) + li_ * 64, GPTR(const float, ap_->in[10]) + li_ * 64, GPTR(const float, ap_->in[14]) + li_ * 1024};
        const int pn = u.pn;
#pragma unroll
        for (int ai = 0; ai < 2; ++ai)
#pragma unroll
          for (int mp = 0; mp < 2; ++mp) {
            f32x4 tabA[2][4];
            if (MODE == 0 && pn < 4) {
#pragma unroll
                for (int mi = 0; mi < 2; ++mi) { const float* tab = EPF(WS_TAB) + ((u.pm * BM + ai * HALF + wr * 64 + (2 * mp + mi) * 16 + fr) & 4095) * 16;
#pragma unroll
                    for (int q = 0; q < 4; ++q) tabA[mi][q] = *(const f32x4*)(tab + 4 * q); } }
#pragma unroll
            for (int mi = 0; mi < 2; ++mi) { const int m = 2 * mp + mi;
                const int row = u.pm * BM + ai * HALF + wr * 64 + m * 16 + fr;
                float v[2][8];
#pragma unroll
                for (int bj = 0; bj < 2; ++bj)
#pragma unroll
                    for (int n = 0; n < 2; ++n)
#pragma unroll
                        for (int e = 0; e < 4; ++e) v[bj][4 * n + e] = acc[ai][bj][m][n][e];
                bf16_t* dst;
                if constexpr (MODE == 0) {
                    const int pos = row & 4095;
                    if (pn < 4) {
                        const f32x4 c0 = tabA[mi][0], c1 = tabA[mi][1], s0 = tabA[mi][2], s1 = tabA[mi][3];
#pragma unroll
                        for (int j = 0; j < 8; ++j) { const float cs = j < 4 ? c0[j & 3] : c1[j & 3], sn = j < 4 ? s0[j & 3] : s1[j & 3];
                            const float other = __shfl_xor(v[0][j], 16); const float r = v[0][j] * cs + other * (fq == 0 ? -sn : sn); if (fq < 2) v[0][j] = r; }
                        if (pn < 2) {
#pragma unroll
                            for (int j = 0; j < 8; ++j) { v[0][j] *= C2F; v[1][j] *= C2F; } }
                        dst = EPB(pn < 2 ? WS_QA : WS_KA) + (size_t)row * 512 + 256 * (pn & 1) + 64 * wc + 8 * fq;
                    } else if (pn < 6) {
                        dst = EPB(WS_VA) + (size_t)row * 512 + 256 * (pn - 4) + 64 * wc + 8 * fq;
                    } else if (pn < 9) {
                        const bool isv = (pn == 8 && wc >= 2);
                        if (!isv) {
                            const float* g = (pn == 8) ? P.knorm : P.qnorm;
                            float ss = 0.f;
#pragma unroll
                            for (int j = 0; j < 8; ++j) ss += v[0][j] * v[0][j] + v[1][j] * v[1][j];
                            ss += __shfl_xor(ss, 16); ss += __shfl_xor(ss, 32);
                            const float rinv = rsqrtf(ss * (1.f / 64.f) + 1e-6f);
#pragma unroll
                            for (int bj = 0; bj < 2; ++bj) { const f32x4 g0 = *(const f32x4*)(g + 32 * bj + 8 * fq), g1 = *(const f32x4*)(g + 32 * bj + 8 * fq + 4);
#pragma unroll
                                for (int j = 0; j < 8; ++j) v[bj][j] *= rinv * (j < 4 ? g0[j & 3] : g1[j & 3]); }
#pragma unroll
                            for (int bj = 0; bj < 2; ++bj) { const int px = bj == 0 ? (pos >> 6) : (pos & 63); const float* tab = EPF(WS_TAB + 4096 * 16 * 4) + px * 32 + 8 * (fq & 1);
                                const f32x4 c0 = *(const f32x4*)(tab), c1 = *(const f32x4*)(tab + 4), s0 = *(const f32x4*)(tab + 16), s1 = *(const f32x4*)(tab + 20);
#pragma unroll
                                for (int j = 0; j < 8; ++j) { const float cs = j < 4 ? c0[j & 3] : c1[j & 3], sn = j < 4 ? s0[j & 3] : s1[j & 3];
                                    const float other = __shfl_xor(v[bj][j], 32); v[bj][j] = v[bj][j] * cs + other * (fq < 2 ? -sn : sn); } }
                            if (pn < 8) {
#pragma unroll
                                for (int j = 0; j < 8; ++j) { v[0][j] *= C2F; v[1][j] *= C2F; } }
                        }
                        if (pn < 8) dst = EPB(WS_QB) + (size_t)row * 512 + 256 * (pn - 6) + 64 * wc + 8 * fq;
                        else if (wc < 2) dst = EPB(WS_KB) + (((size_t)(row >> 12) * 2 + wc) * 4096 + (pos & ~63)) * 64 + fq * 512 + (pos & 63) * 8;
                        else dst = EPB(WS_VB) + (((size_t)(row >> 12) * 2 + (wc - 2)) * 4096 + (pos & ~63)) * 64 + (pos & 63) * 32 + 8 * fq;
                    } else {
#pragma unroll
                        for (int j = 0; j < 8; ++j) { v[0][j] = silu_f(v[0][j]); v[1][j] = silu_f(v[1][j]); }
                        dst = EPB(WS_SG) + (size_t)row * 1024 + 256 * (pn - 9) + 64 * wc + 8 * fq;
                    }
                    st8(dst, v[0]); st8(dst + ((pn == 8) ? 2048 : 32), v[1]);
                } else {
                    const int col = 32 * wc + 8 * fq;
                    if constexpr (MODE == 1) {
                        if (pn < 4) dst = EPB(WS_QA) + (size_t)row * 1024 + 256 * pn + col;
                        else { dst = EPB(WS_SG) + (size_t)row * 1024 + 256 * (pn - 4) + col;
#pragma unroll
                            for (int j = 0; j < 8; ++j) { v[0][j] = silu_f(v[0][j]); v[1][j] = silu_f(v[1][j]); } }
                    } else if constexpr (MODE == 2) {
                        dst = EPB(WS_H) + (size_t)row * 1024 + 256 * pn + col;
#pragma unroll
                        for (int bj = 0; bj < 2; ++bj) { const int cc = 256 * pn + col + 128 * bj; const f32x4 p0 = *(const f32x4*)(P.pscale + cc), p1 = *(const f32x4*)(P.pscale + cc + 4);
                            const u32x4 gv = *(const u32x4*)(EPB(WS_SG) + (size_t)row * 1024 + cc);
#pragma unroll
                            for (int j = 0; j < 8; ++j) { const unsigned w = gv[j >> 1]; const float gf = __uint_as_float((j & 1) ? (w & 0xffff0000u) : (w << 16)); v[bj][j] *= (j < 4 ? p0[j & 3] : p1[j & 3]) * gf; } }
                    } else {
                        dst = EPB(WS_QA) + (size_t)row * 1024 + 256 * pn + col;
                    }
                    st8(dst, v[0]); st8(dst + 128, v[1]);
                }
            }
          }
    }
};
template <class Epi, class Sched, bool ALIGN_EPI = false, bool SP2 = false>
__device__ __forceinline__ void gemm_phase(PG8_LAS unsigned char* lds, const Gemm g, const Sched& S, const Epi& E) {
    int tid_ = threadIdx.x; asm volatile("" : "+v"(tid_));
    const int tid = tid_, wid = __builtin_amdgcn_readfirstlane(tid >> 6), lane = tid & 63, wr = wid >> 2, wc = wid & 3, fr = lane & 15, fq = lane >> 4;
    const char* gA_ = uni_ptr((const char*)g.A); const char* gB_ = uni_ptr((const char*)g.Bt);
    const int K = g.K, nt = K / BK;
    unsigned voffA[2], voffB[2];
#pragma unroll
    for (int i = 0; i < 2; ++i) { int R, C; stage_rc(tid * 16 + i * 8192, R, C); const int Rb = Epi::PERM ? ((R & ~31) + perm32(R & 31)) : R;
        voffA[i] = (unsigned)(R * g.lda + C) * 2u; voffB[i] = (unsigned)(Rb * K + C) * 2u; }
    const size_t kstep = (size_t)(BK * 2);
    const size_t hsA = (size_t)HALF * g.lda * 2, hsB = (size_t)HALF * K * 2;
    const size_t tsA = 2 * hsA, tsB = 2 * hsB;
    const unsigned ldsw = (unsigned)wid * 1024u;
    const int aoff = lds_byte(wr * 64 + fr, fq * 8), boff = lds_byte(wc * 32 + fr, fq * 8);
#define PG8_SA(b, h) (((b) * 2 + (h)) * HTB)
#define PG8_SB(b, h) ((4 + (b) * 2 + (h)) * HTB)
#define PG8_STAGE(bufoff, gbase, voff) do { _Pragma("unroll") for (int _i = 0; _i < 2; ++_i) \
        __builtin_amdgcn_global_load_lds((const unsigned*)((const char*)(gbase) + (voff)[_i]), (PG8_LAS unsigned*)(lds + (bufoff) + ldsw + _i * 8192), 16, 0, 0); } while (0)
#define PG8_LDA(dst, b, h) do { _Pragma("unroll") for (int m = 0; m < 4; ++m) _Pragma("unroll") for (int k = 0; k < 2; ++k) dst[m][k] = *(const PG8_LAS bf16x8*)(lds + PG8_SA(b, h) + aoff + m * 2048 + k * 1024); } while (0)
#define PG8_LDB(dst, b, h) do { _Pragma("unroll") for (int n = 0; n < 2; ++n) _Pragma("unroll") for (int k = 0; k < 2; ++k) dst[n][k] = *(const PG8_LAS bf16x8*)(lds + PG8_SB(b, h) + boff + n * 2048 + k * 1024); } while (0)
#define PG8_MMA(ai, bj, At, Bt) do { __builtin_amdgcn_s_setprio(1); _Pragma("unroll") for (int m = 0; m < 4; ++m) _Pragma("unroll") for (int n = 0; n < 2; ++n) _Pragma("unroll") for (int k = 0; k < 2; ++k) \
        acc[ai][bj][m][n] = __builtin_amdgcn_mfma_f32_16x16x32_bf16(Bt[n][k], At[m][k], acc[ai][bj][m][n], 0, 0, 0); __builtin_amdgcn_s_setprio(0); } while (0)
#define PG8_WAIT_V(n) asm volatile("s_waitcnt vmcnt(" #n ")" ::: "memory")
#define PG8_WAIT_L(n) asm volatile("s_waitcnt lgkmcnt(" #n ")" ::: "memory")
#define PG8_BAR __builtin_amdgcn_s_barrier()
#define PG8_SCHED __builtin_amdgcn_sched_barrier(0)
    Unit cur, nxt; int ui = 0;
    if (!S.next(0, cur)) return;
    f32x4 acc[2][2][4][2];
#pragma unroll
    for (int a = 0; a < 2; ++a)
#pragma unroll
        for (int b = 0; b < 2; ++b)
#pragma unroll
            for (int m = 0; m < 4; ++m)
#pragma unroll
                for (int n = 0; n < 2; ++n) acc[a][b][m][n] = (f32x4){0.f, 0.f, 0.f, 0.f};
    bf16x8 At[4][2], B0[2][2], B1[2][2];
    const char* cA = gA_ + (size_t)cur.pm * tsA + (size_t)cur.pn * g.a_pn_bytes; const char* cB = gB_ + (size_t)cur.pn * tsB;
    S.a_ready(cur);
    if constexpr (SP2) {
        PG8_STAGE(PG8_SB(0, 0), cB, voffB); PG8_STAGE(PG8_SB(0, 1), cB + hsB, voffB); PG8_STAGE(PG8_SA(0, 0), cA, voffA); PG8_STAGE(PG8_SA(0, 1), cA + hsA, voffA);
        if (wr == 1) PG8_BAR;
        PG8_WAIT_V(2); PG8_BAR;
        PG8_STAGE(PG8_SB(1, 0), cB + kstep, voffB); PG8_STAGE(PG8_SA(1, 0), cA + kstep, voffA); PG8_STAGE(PG8_SB(1, 1), cB + hsB + kstep, voffB);
        PG8_WAIT_V(6); PG8_BAR;
    } else {
        PG8_STAGE(PG8_SB(0, 0), cB, voffB); PG8_STAGE(PG8_SA(0, 0), cA, voffA); PG8_STAGE(PG8_SB(0, 1), cB + hsB, voffB); PG8_STAGE(PG8_SA(0, 1), cA + hsA, voffA);
        if (wr == 1) PG8_BAR;
        PG8_WAIT_V(4); PG8_BAR;
        PG8_STAGE(PG8_SB(1, 0), cB + kstep, voffB); PG8_STAGE(PG8_SA(1, 0), cA + kstep, voffA); PG8_STAGE(PG8_SB(1, 1), cB + hsB + kstep, voffB);
        PG8_WAIT_V(6); PG8_BAR;
    }
    for (;;) {
        const bool has_next = S.next(ui + 1, nxt);
        const char* nA = has_next ? gA_ + (size_t)nxt.pm * tsA + (size_t)nxt.pn * g.a_pn_bytes : cA; const char* nB = has_next ? gB_ + (size_t)nxt.pn * tsB : cB;
        for (int t = 0; t < nt; t += 2) {
            const bool last = (t == nt - 2);
            const char* a1 = cA + (size_t)(t + 1) * kstep;
            const char* a2 = last ? nA : cA + (size_t)(t + 2) * kstep; const char* b2 = last ? nB : cB + (size_t)(t + 2) * kstep;
            const char* a3 = a2 + kstep; const char* b3 = b2 + kstep;
            if (last && has_next) S.a_ready(nxt);
            if constexpr (SP2) {
            PG8_LDB(B0, 0, 0); PG8_LDB(B1, 0, 1); PG8_SCHED; PG8_LDA(At, 0, 0); PG8_STAGE(PG8_SA(1, 1), a1 + hsA, voffA);
            PG8_WAIT_V(8); PG8_WAIT_L(0); PG8_BAR; PG8_MMA(0, 0, At, B0); PG8_MMA(0, 1, At, B1); PG8_BAR; PG8_SCHED;
            PG8_LDA(At, 0, 1); PG8_STAGE(PG8_SB(0, 0), b2, voffB); PG8_STAGE(PG8_SB(0, 1), b2 + hsB, voffB); PG8_STAGE(PG8_SA(0, 0), a2, voffA);
            PG8_WAIT_V(8); PG8_WAIT_L(0); PG8_BAR; PG8_MMA(1, 0, At, B0); PG8_MMA(1, 1, At, B1); PG8_BAR; PG8_SCHED;
            PG8_LDB(B0, 1, 0); PG8_LDB(B1, 1, 1); PG8_SCHED; PG8_LDA(At, 1, 0); PG8_STAGE(PG8_SA(0, 1), a2 + hsA, voffA);
            PG8_WAIT_V(8); PG8_WAIT_L(0); PG8_BAR; PG8_MMA(0, 0, At, B0); PG8_MMA(0, 1, At, B1); PG8_BAR; PG8_SCHED;
            PG8_LDA(At, 1, 1); PG8_STAGE(PG8_SB(1, 0), b3, voffB); PG8_STAGE(PG8_SB(1, 1), b3 + hsB, voffB); PG8_STAGE(PG8_SA(1, 0), a3, voffA);
            PG8_WAIT_V(8); PG8_WAIT_L(0); PG8_BAR; PG8_MMA(1, 0, At, B0); PG8_MMA(1, 1, At, B1); PG8_BAR; PG8_SCHED;
            } else {
            PG8_LDB(B0, 0, 0); PG8_SCHED; PG8_LDA(At, 0, 0); PG8_STAGE(PG8_SA(1, 1), a1 + hsA, voffA);
            PG8_WAIT_L(8); PG8_BAR; PG8_WAIT_L(0); PG8_MMA(0, 0, At, B0); PG8_BAR; PG8_SCHED;
            PG8_LDB(B1, 0, 1); PG8_STAGE(PG8_SB(0, 0), b2, voffB);
            PG8_BAR; PG8_WAIT_L(0); PG8_MMA(0, 1, At, B1); PG8_BAR;
            PG8_LDA(At, 0, 1); PG8_STAGE(PG8_SA(0, 0), a2, voffA);
            PG8_BAR; PG8_WAIT_L(0); PG8_MMA(1, 0, At, B0); PG8_BAR; PG8_SCHED;
            PG8_STAGE(PG8_SB(0, 1), b2 + hsB, voffB);
            PG8_WAIT_V(6); PG8_BAR; PG8_MMA(1, 1, At, B1); PG8_BAR;
            PG8_LDB(B0, 1, 0); PG8_SCHED; PG8_LDA(At, 1, 0); PG8_STAGE(PG8_SA(0, 1), a2 + hsA, voffA);
            PG8_WAIT_L(8); PG8_BAR; PG8_WAIT_L(0); PG8_MMA(0, 0, At, B0); PG8_BAR; PG8_SCHED;
            PG8_LDB(B1, 1, 1); PG8_STAGE(PG8_SB(1, 0), b3, voffB);
            PG8_BAR; PG8_WAIT_L(0); PG8_MMA(0, 1, At, B1); PG8_BAR;
            PG8_LDA(At, 1, 1); PG8_STAGE(PG8_SA(1, 0), a3, voffA);
            PG8_BAR; PG8_WAIT_L(0); PG8_MMA(1, 0, At, B0); PG8_BAR; PG8_SCHED;
            PG8_STAGE(PG8_SB(1, 1), b3 + hsB, voffB);
            PG8_WAIT_V(6); PG8_BAR; PG8_MMA(1, 1, At, B1); PG8_BAR;
            }
        }
        if constexpr (ALIGN_EPI) { if (wr == 0) PG8_BAR; }
        if constexpr (!Epi::AFTER_DRAIN) { E(acc, cur, wr, wc, fr, fq); S.done(cur); }
        if (!has_next) break;
#pragma unroll
        for (int a = 0; a < 2; ++a)
#pragma unroll
            for (int b = 0; b < 2; ++b)
#pragma unroll
                for (int m = 0; m < 4; ++m)
#pragma unroll
                    for (int n = 0; n < 2; ++n) acc[a][b][m][n] = (f32x4){0.f, 0.f, 0.f, 0.f};
        cur = nxt; cA = nA; cB = nB; ++ui;
        if constexpr (ALIGN_EPI) { if (wr == 1) PG8_BAR; }
    }
    PG8_WAIT_V(0);
    if constexpr (!ALIGN_EPI) { if (wr == 0) PG8_BAR; }
    PG8_BAR;
    if constexpr (Epi::AFTER_DRAIN) { E.fused(acc, cur, wr, wc, fr, fq, lds, wid, lane); S.done(cur); }
#undef PG8_SA
#undef PG8_SB
#undef PG8_STAGE
#undef PG8_LDA
#undef PG8_LDB
#undef PG8_MMA
#undef PG8_WAIT_V
#undef PG8_WAIT_L
#undef PG8_BAR
#undef PG8_SCHED
}
}
#include <hip/hip_bf16.h>
#include <cmath>
namespace attn_body {
using bf16=__hip_bfloat16;
using bf16x8=__attribute__((ext_vector_type(8)))short;
using s16x4=__attribute__((ext_vector_type(4)))short;
using f32x16=__attribute__((ext_vector_type(16)))float;
using u32x4=__attribute__((ext_vector_type(4)))unsigned;
constexpr int SEQ=4096,D=64,QP=512,KP=128,VP=128,OP=1024;
constexpr int NW=8,QBLK=32,QB=QBLK*NW,KVBLK=64,NQB=SEQ/QB;
constexpr int ATTN_UNIT_ROWS=QB;
__device__ __forceinline__ int crow(int r,int hi){return (r&3)+8*(r>>2)+4*hi;}
#define SBAR() __builtin_amdgcn_sched_barrier(0)
__device__ __forceinline__ void cmask(f32x16&p0,f32x16&p1,int jb,int qrel,int hi){
  const float NEG=-INFINITY; int kb=64*jb+4*hi;
  #pragma unroll
  for(int r=0;r<16;++r){int kv=kb+(r&3)+8*(r>>2); if(kv>qrel)p0[r]=NEG; if(kv+32>qrel)p1[r]=NEG;}
}

constexpr int NSLOT=3, SLOTB=8192;
constexpr int LDS_K=0, LDS_V=NSLOT*SLOTB, LDS_WS=2*NSLOT*SLOTB, LDS_OST=LDS_WS+NW*64*4, LDS_BYTES=LDS_OST+NW*4096;
constexpr float C2=0.125f*1.4426950408889634f;
__device__ __forceinline__ void glds16(const void*gsrc,unsigned lds_dst){unsigned keep;
  asm volatile("s_mov_b32 %0, m0\n\ts_mov_b32 m0, %2\n\ts_nop 0\n\tglobal_load_lds_dwordx4 %1, off\n\ts_mov_b32 m0, %0":"=&s"(keep):"v"(gsrc),"s"(lds_dst):"memory");}
__device__ __forceinline__ float max3f(float a,float b,float c){float r;asm("v_max3_f32 %0, %1, %2, %3":"=v"(r):"v"(a),"v"(b),"v"(c));return r;}
__device__ __forceinline__ float max2f(float a,float b){float r;asm("v_max_f32_e32 %0, %1, %2":"=v"(r):"v"(a),"v"(b));return r;}
__device__ __forceinline__ float fadd_s(float a,float b){float r;asm("v_add_f32_e32 %0, %1, %2":"=v"(r):"v"(a),"v"(b));return r;}
__device__ __forceinline__ float fsub_s(float a,float b){float r;asm("v_sub_f32_e32 %0, %1, %2":"=v"(r):"v"(a),"v"(b));return r;}
typedef float f32x2_t __attribute__((ext_vector_type(2))); typedef __bf16 bf16x2_t __attribute__((ext_vector_type(2)));
__device__ __forceinline__ unsigned cvtpk_s(float lo,float hi){f32x2_t v={lo,hi};bf16x2_t b=__builtin_convertvector(v,bf16x2_t);return __builtin_bit_cast(unsigned,b);}
#define WAIT_BAR(N) asm volatile("s_waitcnt vmcnt(" #N ") lgkmcnt(0)\n\ts_barrier":::"memory")

__device__ __forceinline__ void qkt(f32x16&p0,f32x16&p1,const char*Kslot,const bf16x8*qr,const f32x16&negm,int r32,int hi){
  const char*kb=Kslot+hi*1024+r32*16;
  #pragma unroll
  for(int d0=0;d0<4;++d0){
    const bf16x8 b0=*reinterpret_cast<const bf16x8*>(kb+d0*2048);
    const bf16x8 b1=*reinterpret_cast<const bf16x8*>(kb+d0*2048+512);
    if(d0==0){p0=__builtin_amdgcn_mfma_f32_32x32x16_bf16(b0,qr[0],negm,0,0,0);p1=__builtin_amdgcn_mfma_f32_32x32x16_bf16(b1,qr[0],negm,0,0,0);}
    else{p0=__builtin_amdgcn_mfma_f32_32x32x16_bf16(b0,qr[d0],p0,0,0,0);p1=__builtin_amdgcn_mfma_f32_32x32x16_bf16(b1,qr[d0],p1,0,0,0);}}
}
typedef __attribute__((address_space(3))) const char* lds_cptr;
typedef short v4i16_t __attribute__((ext_vector_type(4)));
__device__ __forceinline__ void kload8(bf16x8*kf,lds_cptr kp){
  kf[0]=*(const __attribute__((address_space(3))) bf16x8*)(kp);      kf[1]=*(const __attribute__((address_space(3))) bf16x8*)(kp+512);
  kf[2]=*(const __attribute__((address_space(3))) bf16x8*)(kp+2048); kf[3]=*(const __attribute__((address_space(3))) bf16x8*)(kp+2560);
  kf[4]=*(const __attribute__((address_space(3))) bf16x8*)(kp+4096); kf[5]=*(const __attribute__((address_space(3))) bf16x8*)(kp+4608);
  kf[6]=*(const __attribute__((address_space(3))) bf16x8*)(kp+6144); kf[7]=*(const __attribute__((address_space(3))) bf16x8*)(kp+6656);
}
__device__ __forceinline__ void kload2(bf16x8*kf,lds_cptr kp,int j){ kf[2*j]=*(const __attribute__((address_space(3))) bf16x8*)(kp+j*2048); kf[2*j+1]=*(const __attribute__((address_space(3))) bf16x8*)(kp+j*2048+512); }
__device__ __forceinline__ s16x4 vtr(lds_cptr p){ return __builtin_bit_cast(s16x4,__builtin_amdgcn_ds_read_tr16_b64_v4i16((__attribute__((address_space(3))) v4i16_t*)p)); }
__device__ __forceinline__ float rowmax(const f32x16&p0,const f32x16&p1){
  float a=max3f(p0[0],p0[1],p1[0]),b=max3f(p0[2],p0[3],p1[1]);a=max3f(a,p1[2],p1[3]);
  #pragma unroll
  for(int r=4;r<16;r+=4){a=max3f(a,p0[r],p0[r+1]);b=max3f(b,p0[r+2],p0[r+3]);a=max3f(a,p1[r],p1[r+1]);b=max3f(b,p1[r+2],p1[r+3]);}
  const float m=max2f(a,b);
  auto rr=__builtin_amdgcn_permlane32_swap(__float_as_uint(m),__float_as_uint(m),false,false);
  return max2f(__uint_as_float(rr[0]),__uint_as_float(rr[1]));
}
__device__ __forceinline__ void pv(f32x16*o,int vb,bf16x8 pa0,bf16x8 pa1,bf16x8 pa2,bf16x8 pa3){
  #pragma unroll
  for(int d0=0;d0<2;++d0){s16x4 lo[4],hi[4];
    #pragma unroll
    for(int ks=0;ks<4;++ks){
      asm volatile("ds_read_b64_tr_b16 %0,%1 offset:%c2":"=&v"(lo[ks]):"v"(vb),"i"(d0*4096+ks*1024):"memory");
      asm volatile("ds_read_b64_tr_b16 %0,%1 offset:%c2":"=&v"(hi[ks]):"v"(vb),"i"(d0*4096+ks*1024+512):"memory");}
    asm volatile("s_waitcnt lgkmcnt(0)":::"memory");SBAR();
    #define PK(k) (bf16x8){lo[k][0],lo[k][1],lo[k][2],lo[k][3],hi[k][0],hi[k][1],hi[k][2],hi[k][3]}
    o[d0]=__builtin_amdgcn_mfma_f32_32x32x16_bf16(pa0,PK(0),o[d0],0,0,0);
    o[d0]=__builtin_amdgcn_mfma_f32_32x32x16_bf16(pa1,PK(1),o[d0],0,0,0);
    o[d0]=__builtin_amdgcn_mfma_f32_32x32x16_bf16(pa2,PK(2),o[d0],0,0,0);
    o[d0]=__builtin_amdgcn_mfma_f32_32x32x16_bf16(pa3,PK(3),o[d0],0,0,0);
    #undef PK
  }
}

__device__ __forceinline__ u32x4 mulgate(u32x4 v,u32x4 g){ u32x4 r;
  #pragma unroll
  for(int i=0;i<4;++i){ const float a0=__uint_as_float(v[i]<<16),a1=__uint_as_float(v[i]&0xffff0000u),g0=__uint_as_float(g[i]<<16),g1=__uint_as_float(g[i]&0xffff0000u); r[i]=cvtpk_s(a0*g0,a1*g1);} return r; }
#ifndef ATTN_STORE16
#define ATTN_STORE16(p,v) (*(u32x4*)(p)=(v))
#endif
template<int THRL> __device__ __forceinline__ void attn_unit(int b,int h,int qb,const bf16*Q,const bf16*__restrict__ K,const bf16*__restrict__ V,bf16*O,const bf16*SG,char*shm,bool pre,bf16x8*qio,bool has_next,int nb,int nh,int nqb){
  int tid_=threadIdx.x; asm volatile("":"+v"(tid_)); const int tid=tid_,lane=tid&63,r32=lane&31,hi=lane>>5; const int wid=__builtin_amdgcn_readfirstlane(tid>>6);
  const long rowbase=(long)b*SEQ; const int q0=qb*QB;
  const bf16*Qw=Q+(rowbase+q0+wid*QBLK)*QP+h*D;
  const bf16*Kh=K+((long)b*2+(h>>2))*SEQ*D,*Vh=V+((long)b*2+(h>>2))*SEQ*D;
  const unsigned lds0=(unsigned)(uintptr_t)shm;
  float*wsf=(float*)(shm+LDS_WS)+wid*64;
  const bf16*ksrc=Kh+wid*512+lane*8;
  const bf16*vsrc=Vh+(wid>>2)*2048+(16*(wid&3)+(lane>>2))*32+(lane&3)*8;
  const unsigned kdst=lds0+LDS_K+wid*1024, vdst=lds0+LDS_V+wid*1024;
  #define DMA_K(t,slot) glds16(ksrc+(long)(t)*KVBLK*D,(unsigned)__builtin_amdgcn_readfirstlane(kdst+(slot)))
  #define DMA_V(t,slot) glds16(vsrc+(long)(t)*KVBLK*D,(unsigned)__builtin_amdgcn_readfirstlane(vdst+(slot)))
  const int vb0=(int)(lds0+LDS_V)+((lane>>4)&1)*32+(lane&3)*8+(4*hi+((lane&15)>>2))*64;
  const char*Kbase=shm+LDS_K; bf16x8 kf[8];
  const lds_cptr shm3=(lds_cptr)shm; const lds_cptr kp0=shm3+LDS_K+hi*1024+r32*16; const lds_cptr vp0=shm3+LDS_V+((lane>>4)&1)*32+(lane&3)*8+(4*hi+((lane&15)>>2))*64;
  const int NT=SEQ/KVBLK;
  if(!pre){DMA_K(0,0);DMA_V(0,0);DMA_K(1,SLOTB);}
  bf16x8 qr[4];
  #pragma unroll
  for(int d0=0;d0<4;++d0)qr[d0]=*reinterpret_cast<const bf16x8*>(&Qw[(long)r32*QP+d0*16+hi*8]);
  float mhat=0.f,l_reg=0.f;f32x16 o[2];o[0]=f32x16{};o[1]=f32x16{};f32x16 negm=f32x16{};asm volatile("":"+v"(negm));

  #define CMASK(P0,P1,t) do{}while(0)
  bool resc=false;
  #define START(P0,P1) do{ const float rm=rowmax(P0,P1); resc=false; \
    { const float dl=rm; mhat=fadd_s(mhat,dl); \
      _Pragma("unroll") for(int r=0;r<16;++r){P0[r]=fsub_s(P0[r],dl);P1[r]=fsub_s(P1[r],dl);} \
      _Pragma("unroll") for(int r=0;r<16;++r)negm[r]=-mhat; asm volatile("":"+v"(negm)); } \
    _Pragma("unroll") for(int r=0;r<16;++r)P0[r]=__builtin_amdgcn_exp2f(P0[r]); }while(0)
  #define RESC() do{ if(resc){ asm volatile("s_waitcnt lgkmcnt(0)":::"memory"); \
      _Pragma("unroll") for(int d_=0;d_<2;++d_) _Pragma("unroll") for(int r=0;r<16;++r)o[d_][r]*=wsf[crow(r,hi)]; } }while(0)
  f32x16 pA0,pA1,pB0,pB1;
  int sl_prev=0,sl_cur=0,sl_next=SLOTB;
  #define ROT() do{sl_prev=sl_cur;sl_cur=sl_next;sl_next=(sl_next==(NSLOT-1)*SLOTB)?0:sl_next+SLOTB;}while(0)
  if(!pre)DMA_K(2,2*SLOTB);
  WAIT_BAR(3);
  qkt(pA0,pA1,Kbase,qr,negm,r32,hi);asm volatile("s_nop 15\n\ts_nop 7":"+v"(pA0),"+v"(pA1));CMASK(pA0,pA1,0);
  START(pA0,pA1);
  _Pragma("unroll") for(int r=0;r<16;++r)pA1[r]=__builtin_amdgcn_exp2f(pA1[r]);
  WAIT_BAR(0);
  DMA_K(3,0);DMA_V(1,SLOTB);
  ROT();
  kload8(kf,kp0+sl_cur);
  WAIT_BAR(2);
  s16x4 vlo[8],vhi[8]; u32x4 pw0,pw1,pw2,pw3;
  #define PKW(P,B) cvtpk_s(P[B],P[B+1])
  #define PAF(k) __builtin_bit_cast(bf16x8,pw##k)
  #define VFR(i) (bf16x8){vlo[i][0],vlo[i][1],vlo[i][2],vlo[i][3],vhi[i][0],vhi[i][1],vhi[i][2],vhi[i][3]}
  #define PIN(x) asm volatile("":"+v"(x))
  #define MX3(a,b,c) __builtin_fmaxf(__builtin_fmaxf((a),(b)),(c))
  #define GAPA(MF,A0,A1,A2,A3,W0,W1,PW) do{ MF; sacc+=A0; sacc+=A1; sacc+=A2; sacc+=A3; PIN(sacc); W0; W1; PIN(PW); SBAR(); }while(0)
  #define EX(v) __builtin_amdgcn_exp2f(v)
  #define GAPB(MF,X,B) do{ MF; X[B]=EX(X[B]); X[B+1]=EX(X[B+1]); X[B+2]=EX(X[B+2]); X[B+3]=EX(X[B+3]); PIN(X); SBAR(); }while(0)
  #define VRD(i) do{ vlo[i]=vtr(vp_+(((i)>>2)*4096+((i)&3)*1024)); vhi[i]=vtr(vp_+(((i)>>2)*4096+((i)&3)*1024+512)); }while(0)
  #define KRD(G,j) do{ if(G){ kload2(kf,kp0+sl_next,j); SBAR(); } }while(0)
  #define STEP(C0,C1,P0,P1,t,GK,GV,GL) do{ SBAR(); \
    const lds_cptr vp_=vp0+sl_prev; \
    VRD(0); SBAR(); float sacc=(P0[0]+P0[1]); \
    GAPA(C0=__builtin_amdgcn_mfma_f32_32x32x16_bf16(kf[0],qr[0],negm,0,0,0), P0[2],P0[3],P0[4],P0[5],     pw0[0]=PKW(P0,0), pw0[1]=PKW(P0,2), pw0); \
    VRD(4); SBAR(); GAPA(C1=__builtin_amdgcn_mfma_f32_32x32x16_bf16(kf[1],qr[0],negm,0,0,0), P0[6],P0[7],P0[8],P0[9],     pw0[2]=PKW(P0,4), pw0[3]=PKW(P0,6), pw0); \
    VRD(1); SBAR(); GAPA(C0=__builtin_amdgcn_mfma_f32_32x32x16_bf16(kf[2],qr[1],C0,0,0,0),   P0[10],P0[11],P0[12],P0[13], pw1[0]=PKW(P0,8), pw1[1]=PKW(P0,10), pw1); \
    VRD(5); SBAR(); GAPA(C1=__builtin_amdgcn_mfma_f32_32x32x16_bf16(kf[3],qr[1],C1,0,0,0),   P0[14],P0[15],P1[0],P1[1],   pw1[2]=PKW(P0,12),pw1[3]=PKW(P0,14), pw1); \
    VRD(2); SBAR(); GAPA(C0=__builtin_amdgcn_mfma_f32_32x32x16_bf16(kf[4],qr[2],C0,0,0,0),   P1[2],P1[3],P1[4],P1[5],     pw2[0]=PKW(P1,0), pw2[1]=PKW(P1,2), pw2); \
    VRD(6); SBAR(); GAPA(C1=__builtin_amdgcn_mfma_f32_32x32x16_bf16(kf[5],qr[2],C1,0,0,0),   P1[6],P1[7],P1[8],P1[9],     pw2[2]=PKW(P1,4), pw2[3]=PKW(P1,6), pw2); \
    VRD(3); SBAR(); GAPA(C0=__builtin_amdgcn_mfma_f32_32x32x16_bf16(kf[6],qr[3],C0,0,0,0),   P1[10],P1[11],P1[12],P1[13], pw3[0]=PKW(P1,8), pw3[1]=PKW(P1,10), pw3); \
    VRD(7); SBAR(); GAPA(C1=__builtin_amdgcn_mfma_f32_32x32x16_bf16(kf[7],qr[3],C1,0,0,0),   P1[14],P1[15],0.f,0.f,       pw3[2]=PKW(P1,12),pw3[3]=PKW(P1,14), pw3); \
    l_reg+=sacc; \
    if(GK){DMA_K((t)+3,sl_cur);} if(GV){DMA_V((t)+1,sl_next);} \
    CMASK(C0,C1,t); \
    { float a=MX3(C0[0],C0[1],C1[0]),b=MX3(C0[2],C0[3],C1[1]); a=MX3(a,C1[2],C1[3]); \
      _Pragma("unroll") for(int r=4;r<16;r+=4){a=MX3(a,C0[r],C0[r+1]);b=MX3(b,C0[r+2],C0[r+3]);a=MX3(a,C1[r],C1[r+1]);b=MX3(b,C1[r+2],C1[r+3]);} \
      float rm=__builtin_fmaxf(a,b); { auto rr=__builtin_amdgcn_permlane32_swap(__float_as_uint(rm),__float_as_uint(rm),false,false); rm=__builtin_fmaxf(__uint_as_float(rr[0]),__uint_as_float(rr[1])); } \
      resc=false; \
      if(__builtin_expect(__any(rm>(float)THRL),0)){ const float dl=__builtin_fmaxf(rm,0.f); mhat+=dl; \
        _Pragma("unroll") for(int r=0;r<16;++r){C0[r]-=dl;C1[r]-=dl;} \
        _Pragma("unroll") for(int r=0;r<16;++r)negm[r]=-mhat; asm volatile("":"+v"(negm)); \
        const float f=__builtin_amdgcn_exp2f(-dl); l_reg*=f; if(hi==0)wsf[r32]=f; resc=true; } } \
    SBAR(); \
    GAPB(o[0]=__builtin_amdgcn_mfma_f32_32x32x16_bf16(PAF(0),VFR(0),o[0],0,0,0), C0,0); \
    GAPB(o[1]=__builtin_amdgcn_mfma_f32_32x32x16_bf16(PAF(0),VFR(4),o[1],0,0,0), C0,4); \
    KRD(GL,0); GAPB(o[0]=__builtin_amdgcn_mfma_f32_32x32x16_bf16(PAF(1),VFR(1),o[0],0,0,0), C0,8); \
    KRD(GL,1); GAPB(o[1]=__builtin_amdgcn_mfma_f32_32x32x16_bf16(PAF(1),VFR(5),o[1],0,0,0), C0,12); \
    KRD(GL,2); GAPB(o[0]=__builtin_amdgcn_mfma_f32_32x32x16_bf16(PAF(2),VFR(2),o[0],0,0,0), C1,0); \
    KRD(GL,3); GAPB(o[1]=__builtin_amdgcn_mfma_f32_32x32x16_bf16(PAF(2),VFR(6),o[1],0,0,0), C1,4); \
    GAPB(o[0]=__builtin_amdgcn_mfma_f32_32x32x16_bf16(PAF(3),VFR(3),o[0],0,0,0), C1,8); \
    GAPB(o[1]=__builtin_amdgcn_mfma_f32_32x32x16_bf16(PAF(3),VFR(7),o[1],0,0,0), C1,12); \
    }while(0)
  int t=1;
  #undef CMASK
  #define CMASK(P0,P1,t) do{}while(0)
  for(;t+5<NT;t+=2){
    STEP(pB0,pB1,pA0,pA1,t,true,true,true);     WAIT_BAR(2); RESC(); ROT();
    STEP(pA0,pA1,pB0,pB1,t+1,true,true,true);   WAIT_BAR(2); RESC(); ROT();
  }
  #undef CMASK
  #define CMASK(P0,P1,t) do{}while(0)
  #define ENDW(tt) do{ if((tt)+3<NT){WAIT_BAR(2);} else if((tt)+2<NT){WAIT_BAR(1);} else {WAIT_BAR(0);} }while(0)
  for(;t+1<NT;t+=2){
    STEP(pB0,pB1,pA0,pA1,t,(t+3<NT),(t+1<NT),(t+1<NT));       ENDW(t);   RESC(); ROT();
    STEP(pA0,pA1,pB0,pB1,t+1,(t+4<NT),(t+2<NT),(t+2<NT));     ENDW(t+1); RESC(); ROT();
  }
  STEP(pB0,pB1,pA0,pA1,NT-1,false,false,false); RESC();
  { float sacc=pB0[0]+pB0[1]; _Pragma("unroll") for(int r=2;r<16;++r)sacc+=pB0[r]; _Pragma("unroll") for(int r=0;r<16;++r)sacc+=pB1[r]; l_reg+=sacc;
    pw0=(u32x4){PKW(pB0,0),PKW(pB0,2),PKW(pB0,4),PKW(pB0,6)};pw1=(u32x4){PKW(pB0,8),PKW(pB0,10),PKW(pB0,12),PKW(pB0,14)};pw2=(u32x4){PKW(pB1,0),PKW(pB1,2),PKW(pB1,4),PKW(pB1,6)};pw3=(u32x4){PKW(pB1,8),PKW(pB1,10),PKW(pB1,12),PKW(pB1,14)};
    SBAR(); pv(o,vb0+sl_cur,PAF(0),PAF(1),PAF(2),PAF(3)); }
  if(has_next){ asm volatile("s_waitcnt lgkmcnt(0)\n\ts_barrier":::"memory");
    const long nrb=(long)nb*SEQ; const bf16*nKh=K+((long)nb*2+(nh>>2))*SEQ*D,*nVh=V+((long)nb*2+(nh>>2))*SEQ*D;
    const bf16*nks=nKh+wid*512+lane*8; const bf16*nvs=nVh+(wid>>2)*2048+(16*(wid&3)+(lane>>2))*32+(lane&3)*8;
    glds16(nks,(unsigned)__builtin_amdgcn_readfirstlane(kdst)); glds16(nvs,(unsigned)__builtin_amdgcn_readfirstlane(vdst)); glds16(nks+(long)KVBLK*D,(unsigned)__builtin_amdgcn_readfirstlane(kdst+SLOTB));
    (void)nrb; (void)nqb; (void)qio;
    glds16(nks+(long)2*KVBLK*D,(unsigned)__builtin_amdgcn_readfirstlane(kdst+2*SLOTB)); }
  #undef PKW
  #undef PAF
  #undef VFR
  #undef PIN
  #undef MX3
  #undef GAPA
  #undef GAPB
  #undef EX
  #undef VRD
  #undef KRD
  #undef STEP
  #undef ENDW
  {auto rr=__builtin_amdgcn_permlane32_swap(__float_as_uint(l_reg),__float_as_uint(l_reg),false,false);l_reg=__uint_as_float(rr[0])+__uint_as_float(rr[1]);}
  if(hi==0)wsf[32+r32]=l_reg;asm volatile("s_waitcnt lgkmcnt(0)":::"memory");
  float rli[16];
  #pragma unroll
  for(int r=0;r<16;++r)rli[r]=__builtin_amdgcn_rcpf(wsf[32+crow(r,hi)]);
  bf16*Ow=O+(rowbase+q0+wid*QBLK)*OP+512+h*D; const bf16*Gw=SG+(rowbase+q0+wid*QBLK)*OP+512+h*D;
  { bf16*stg=(bf16*)(shm+LDS_OST)+wid*2048;
    #pragma unroll
    for(int r=0;r<16;++r){const int orow=crow(r,hi);
      #pragma unroll
      for(int d0=0;d0<2;++d0)stg[orow*64+d0*32+r32]=__float2bfloat16(o[d0][r]*rli[r]);}
    asm volatile("s_waitcnt lgkmcnt(0)":::"memory");
    #pragma unroll
    for(int i=0;i<4;++i){const int row=i*8+(lane>>3),ch=lane&7; u32x4 v=*(const u32x4*)(stg+row*64+ch*8); const u32x4 gv=*(const u32x4*)(Gw+(long)row*OP+ch*8); v=mulgate(v,gv); ATTN_STORE16(Ow+(long)row*OP+ch*8,v);} }
  if(!has_next)asm volatile("s_waitcnt lgkmcnt(0)\n\ts_barrier":::"memory");
  else asm volatile("s_waitcnt lgkmcnt(0)":::"memory");
  #undef DMA_K
  #undef DMA_V
  #undef CMASK
  #undef START
  #undef RESC
  #undef ROT
}
constexpr int ATTN_LDS_BYTES=LDS_BYTES;
#undef SBAR
#undef WAIT_BAR
}
namespace win {
using attn_body::bf16; using attn_body::bf16x8; using attn_body::s16x4; using attn_body::f32x16; using attn_body::u32x4;
typedef __attribute__((address_space(3))) char* lptr;
#define WIN_WAITV0() asm volatile("s_waitcnt vmcnt(0)" ::: "memory")
#define WIN_WAITL0() asm volatile("s_waitcnt lgkmcnt(0)" ::: "memory")
__device__ __forceinline__ int clampi(int v, int lo, int hi) { return v < lo ? lo : (v > hi ? hi : v); }
__device__ __forceinline__ void issue_tile(bf16x8* kf, const bf16* Kc, const bf16* Vc, int k0, int L, int ld, int r32, int hi, int lane, unsigned vdst) {
#pragma unroll
  for (int s = 0; s < 2; ++s) { const int key = clampi(k0 + r32 + 32 * s, 0, L - 1); const bf16* kr = Kc + ((long)key << ld) * 512 + hi * 8;
#pragma unroll
    for (int j = 0; j < 4; ++j) kf[2 * j + s] = *reinterpret_cast<const bf16x8*>(kr + j * 16); }
#pragma unroll
  for (int w = 0; w < 8; ++w) { const int key = clampi(k0 + 16 * (w & 3) + (lane >> 2), 0, L - 1);
    attn_body::glds16(Vc + ((long)key << ld) * 512 + (w >> 2) * 32 + (lane & 3) * 8, (unsigned)__builtin_amdgcn_readfirstlane(vdst + w * 1024)); }
}
__device__ __forceinline__ void tile_step(const bf16x8* kf, const bf16x8* qr, f32x16* o, float& mrun, float& lrun, int k0, int qi, int L, int hi, int r32, int vb, volatile __attribute__((address_space(3))) float* wsf) {
  f32x16 p0 = f32x16{}, p1 = f32x16{};
#pragma unroll
  for (int d0 = 0; d0 < 4; ++d0) { p0 = __builtin_amdgcn_mfma_f32_32x32x16_bf16(kf[2 * d0], qr[d0], p0, 0, 0, 0); p1 = __builtin_amdgcn_mfma_f32_32x32x16_bf16(kf[2 * d0 + 1], qr[d0], p1, 0, 0, 0); }
#pragma unroll
  for (int r = 0; r < 16; ++r) { const int kk = k0 + attn_body::crow(r, hi); const int d0_ = kk - qi, d1_ = d0_ + 32;
    const bool ok0 = (kk >= 0) && (kk < L) && (d0_ <= 64) && (d0_ >= -64); const bool ok1 = (kk + 32 >= 0) && (kk + 32 < L) && (d1_ <= 64) && (d1_ >= -64);
    p0[r] = ok0 ? p0[r] : -1e30f; p1[r] = ok1 ? p1[r] : -1e30f; }
  float rm = p0[0];
#pragma unroll
  for (int r = 1; r < 16; ++r) rm = fmaxf(rm, p0[r]);
#pragma unroll
  for (int r = 0; r < 16; ++r) rm = fmaxf(rm, p1[r]);
  { auto rr = __builtin_amdgcn_permlane32_swap(__float_as_uint(rm), __float_as_uint(rm), false, false); rm = fmaxf(__uint_as_float(rr[0]), __uint_as_float(rr[1])); }
  const float mnew = fmaxf(mrun, rm); const float alpha = __builtin_amdgcn_exp2f(mrun - mnew); mrun = mnew;
  float s = 0.f;
#pragma unroll
  for (int r = 0; r < 16; ++r) { p0[r] = __builtin_amdgcn_exp2f(p0[r] - mnew); p1[r] = __builtin_amdgcn_exp2f(p1[r] - mnew); s += p0[r] + p1[r]; }
  lrun = lrun * alpha + s;
  if (__any(alpha != 1.f)) {
    if (hi == 0) wsf[r32] = alpha;
    WIN_WAITL0();
#pragma unroll
    for (int r = 0; r < 16; ++r) { const float f = wsf[attn_body::crow(r, hi)]; o[0][r] *= f; o[1][r] *= f; }
  }
  u32x4 pw0, pw1, pw2, pw3;
#define WPK(P, B) attn_body::cvtpk_s(P[B], P[B + 1])
  pw0 = (u32x4){WPK(p0, 0), WPK(p0, 2), WPK(p0, 4), WPK(p0, 6)}; pw1 = (u32x4){WPK(p0, 8), WPK(p0, 10), WPK(p0, 12), WPK(p0, 14)};
  pw2 = (u32x4){WPK(p1, 0), WPK(p1, 2), WPK(p1, 4), WPK(p1, 6)}; pw3 = (u32x4){WPK(p1, 8), WPK(p1, 10), WPK(p1, 12), WPK(p1, 14)};
#undef WPK
  __builtin_amdgcn_sched_barrier(0);
  attn_body::pv(o, vb, __builtin_bit_cast(bf16x8, pw0), __builtin_bit_cast(bf16x8, pw1), __builtin_bit_cast(bf16x8, pw2), __builtin_bit_cast(bf16x8, pw3));
}
__device__ __forceinline__ void win_task(int b, int h, int ld, int c, int i0, const bf16* QA, const bf16* KA, const bf16* VA, bf16* OA, float* LSE, lptr wl, volatile __attribute__((address_space(3))) float* wsf, int lane) {
  const int r32 = lane & 31, hi = lane >> 5; const int L = 4096 >> ld; const long rowbase = (long)b * 4096;
  const bf16* Kc = KA + (rowbase + c) * 512 + h * 64; const bf16* Vc = VA + (rowbase + c) * 512 + h * 64;
  const unsigned vdst = (unsigned)(uintptr_t)wl;
  const int vb0 = (int)vdst + ((lane >> 4) & 1) * 32 + (lane & 3) * 8 + (4 * hi + ((lane & 15) >> 2)) * 64;
  bf16x8 kfA[8], kfB[8], kfC[8];
  issue_tile(kfA, Kc, Vc, i0, L, ld, r32, hi, lane, vdst);
  const bf16* Qrow = QA + (rowbase + ((long)(i0 + r32) << ld) + c) * 512 + h * 64 + hi * 8;
  bf16x8 qr[4];
#pragma unroll
  for (int d0 = 0; d0 < 4; ++d0) qr[d0] = *reinterpret_cast<const bf16x8*>(Qrow + d0 * 16);
  f32x16 o[2]; o[0] = f32x16{}; o[1] = f32x16{}; float mrun = -1e30f, lrun = 0.f; const int qi = i0 + r32;
  WIN_WAITV0(); issue_tile(kfB, Kc, Vc, i0 - 64, L, ld, r32, hi, lane, vdst + 8192);
  tile_step(kfA, qr, o, mrun, lrun, i0, qi, L, hi, r32, vb0, wsf);
  WIN_WAITV0(); issue_tile(kfC, Kc, Vc, i0 + 64, L, ld, r32, hi, lane, vdst);
  tile_step(kfB, qr, o, mrun, lrun, i0 - 64, qi, L, hi, r32, vb0 + 8192, wsf);
  WIN_WAITV0();
  tile_step(kfC, qr, o, mrun, lrun, i0 + 64, qi, L, hi, r32, vb0, wsf);
  { auto rr = __builtin_amdgcn_permlane32_swap(__float_as_uint(lrun), __float_as_uint(lrun), false, false); lrun = __uint_as_float(rr[0]) + __uint_as_float(rr[1]); }
  const long tok = rowbase + ((long)qi << ld) + c;
  if (hi == 0) { wsf[32 + r32] = lrun; LSE[tok * 8 + h] = mrun + __builtin_amdgcn_logf(lrun); }
  WIN_WAITL0();
  __attribute__((address_space(3))) unsigned short* stg = (__attribute__((address_space(3))) unsigned short*)(wl + 8192);
#pragma unroll
  for (int r = 0; r < 16; ++r) { const int orow = attn_body::crow(r, hi); const float rl = __builtin_amdgcn_rcpf(wsf[32 + orow]);
#pragma unroll
    for (int d0 = 0; d0 < 2; ++d0) stg[orow * 64 + d0 * 32 + r32] = (unsigned short)(attn_body::cvtpk_s(o[d0][r] * rl, 0.f) & 0xffffu); }
  WIN_WAITL0();
#pragma unroll
  for (int i = 0; i < 4; ++i) { const int row = i * 8 + (lane >> 3), ch = lane & 7; const u32x4 v = *(const __attribute__((address_space(3))) u32x4*)(stg + row * 64 + ch * 8);
    *(u32x4*)(OA + (rowbase + ((long)(i0 + row) << ld) + c) * 512 + h * 64 + ch * 8) = v; }
  WIN_WAITL0();
}
template <int S> __device__ __forceinline__ void tile_step2(const bf16x8* kf, const bf16x8* qr, f32x16* o, f32x16& negm, float& mrun, float& lrun, int k0, int qi, int L, int hi, int r32, int vb, volatile __attribute__((address_space(3))) float* wsf) {
  f32x16 p0, p1;
  if (S == 0) { p0 = __builtin_amdgcn_mfma_f32_32x32x16_bf16(kf[0], qr[0], f32x16{}, 0, 0, 0); p1 = __builtin_amdgcn_mfma_f32_32x32x16_bf16(kf[1], qr[0], f32x16{}, 0, 0, 0); }
  else { p0 = __builtin_amdgcn_mfma_f32_32x32x16_bf16(kf[0], qr[0], negm, 0, 0, 0); p1 = __builtin_amdgcn_mfma_f32_32x32x16_bf16(kf[1], qr[0], negm, 0, 0, 0); }
#pragma unroll
  for (int d0 = 1; d0 < 4; ++d0) { p0 = __builtin_amdgcn_mfma_f32_32x32x16_bf16(kf[2 * d0], qr[d0], p0, 0, 0, 0); p1 = __builtin_amdgcn_mfma_f32_32x32x16_bf16(kf[2 * d0 + 1], qr[d0], p1, 0, 0, 0); }
  if (S != 0) {
    const int dlt = k0 - qi; int lo = (-64 - dlt) > (-k0) ? (-64 - dlt) : (-k0); int up = (64 - dlt) < (L - 1 - k0) ? (64 - dlt) : (L - 1 - k0); lo -= 4 * hi; up -= 4 * hi;
#pragma unroll
    for (int r = 0; r < 16; ++r) { const int c0 = (r & 3) + 8 * (r >> 2), c1 = c0 + 32;
      p0[r] = (c0 >= lo && c0 <= up) ? p0[r] : -1e30f; p1[r] = (c1 >= lo && c1 <= up) ? p1[r] : -1e30f; }
  }
  float rm = attn_body::rowmax(p0, p1);
  if (S == 0) {
    mrun = rm;
#pragma unroll
    for (int r = 0; r < 16; ++r) { p0[r] -= rm; p1[r] -= rm; negm[r] = -rm; }
  } else if (__any(rm > 8.f)) {
    const float dl = fmaxf(rm, 0.f); mrun += dl; const float alpha = __builtin_amdgcn_exp2f(-dl); lrun *= alpha;
#pragma unroll
    for (int r = 0; r < 16; ++r) { p0[r] -= dl; p1[r] -= dl; negm[r] = -mrun; }
    if (hi == 0) wsf[r32] = alpha;
    WIN_WAITL0();
#pragma unroll
    for (int r = 0; r < 16; ++r) { const float f = wsf[attn_body::crow(r, hi)]; o[0][r] *= f; o[1][r] *= f; }
  }
  float sA = 0.f, sB = 0.f;
#pragma unroll
  for (int r = 0; r < 16; ++r) { p0[r] = __builtin_amdgcn_exp2f(p0[r]); p1[r] = __builtin_amdgcn_exp2f(p1[r]); sA += p0[r]; sB += p1[r]; }
  lrun += sA + sB;
  u32x4 pw0, pw1, pw2, pw3;
#define WPK(P, B) attn_body::cvtpk_s(P[B], P[B + 1])
  pw0 = (u32x4){WPK(p0, 0), WPK(p0, 2), WPK(p0, 4), WPK(p0, 6)}; pw1 = (u32x4){WPK(p0, 8), WPK(p0, 10), WPK(p0, 12), WPK(p0, 14)};
  pw2 = (u32x4){WPK(p1, 0), WPK(p1, 2), WPK(p1, 4), WPK(p1, 6)}; pw3 = (u32x4){WPK(p1, 8), WPK(p1, 10), WPK(p1, 12), WPK(p1, 14)};
#undef WPK
  __builtin_amdgcn_sched_barrier(0);
  attn_body::pv(o, vb, __builtin_bit_cast(bf16x8, pw0), __builtin_bit_cast(bf16x8, pw1), __builtin_bit_cast(bf16x8, pw2), __builtin_bit_cast(bf16x8, pw3));
}
template <int HS> __device__ __forceinline__ void tile_half(const bf16x8* kf, const bf16x8* qr, f32x16* o, f32x16& negm, float& mrun, float& lrun, int k0, int qi, int L, int hi, int r32, int vb, volatile __attribute__((address_space(3))) float* wsf) {
  f32x16 p = __builtin_amdgcn_mfma_f32_32x32x16_bf16(kf[HS], qr[0], negm, 0, 0, 0);
#pragma unroll
  for (int d0 = 1; d0 < 4; ++d0) p = __builtin_amdgcn_mfma_f32_32x32x16_bf16(kf[2 * d0 + HS], qr[d0], p, 0, 0, 0);
  { const int dlt = k0 - qi; int lo = (-64 - dlt) > (-k0) ? (-64 - dlt) : (-k0); int up = (64 - dlt) < (L - 1 - k0) ? (64 - dlt) : (L - 1 - k0); lo -= 4 * hi; up -= 4 * hi;
#pragma unroll
    for (int r = 0; r < 16; ++r) { const int c = (r & 3) + 8 * (r >> 2) + 32 * HS; p[r] = (c >= lo && c <= up) ? p[r] : -1e30f; } }
  float rm = fmaxf(fmaxf(p[0], p[1]), p[2]);
#pragma unroll
  for (int r = 3; r < 15; r += 2) rm = fmaxf(fmaxf(rm, p[r]), p[r + 1]);
  rm = fmaxf(rm, p[15]);
  { auto rr = __builtin_amdgcn_permlane32_swap(__float_as_uint(rm), __float_as_uint(rm), false, false); rm = fmaxf(__uint_as_float(rr[0]), __uint_as_float(rr[1])); }
  if (__any(rm > 8.f)) {
    const float dl = fmaxf(rm, 0.f); mrun += dl; const float alpha = __builtin_amdgcn_exp2f(-dl); lrun *= alpha;
#pragma unroll
    for (int r = 0; r < 16; ++r) { p[r] -= dl; negm[r] = -mrun; }
    if (hi == 0) wsf[r32] = alpha;
    WIN_WAITL0();
#pragma unroll
    for (int r = 0; r < 16; ++r) { const float f = wsf[attn_body::crow(r, hi)]; o[0][r] *= f; o[1][r] *= f; }
  }
  float sA = 0.f;
#pragma unroll
  for (int r = 0; r < 16; ++r) { p[r] = __builtin_amdgcn_exp2f(p[r]); sA += p[r]; }
  lrun += sA;
  u32x4 pwA, pwB;
#define WPK(P, B) attn_body::cvtpk_s(P[B], P[B + 1])
  pwA = (u32x4){WPK(p, 0), WPK(p, 2), WPK(p, 4), WPK(p, 6)}; pwB = (u32x4){WPK(p, 8), WPK(p, 10), WPK(p, 12), WPK(p, 14)};
#undef WPK
  __builtin_amdgcn_sched_barrier(0);
#pragma unroll
  for (int d0 = 0; d0 < 2; ++d0) { s16x4 lo0, hi0, lo1, hi1;
    asm volatile("ds_read_b64_tr_b16 %0,%1 offset:%c2" : "=&v"(lo0) : "v"(vb), "i"(d0 * 4096 + (2 * HS) * 1024) : "memory");
    asm volatile("ds_read_b64_tr_b16 %0,%1 offset:%c2" : "=&v"(hi0) : "v"(vb), "i"(d0 * 4096 + (2 * HS) * 1024 + 512) : "memory");
    asm volatile("ds_read_b64_tr_b16 %0,%1 offset:%c2" : "=&v"(lo1) : "v"(vb), "i"(d0 * 4096 + (2 * HS + 1) * 1024) : "memory");
    asm volatile("ds_read_b64_tr_b16 %0,%1 offset:%c2" : "=&v"(hi1) : "v"(vb), "i"(d0 * 4096 + (2 * HS + 1) * 1024 + 512) : "memory");
    asm volatile("s_waitcnt lgkmcnt(0)" ::: "memory"); __builtin_amdgcn_sched_barrier(0);
    o[d0] = __builtin_amdgcn_mfma_f32_32x32x16_bf16(__builtin_bit_cast(bf16x8, pwA), (bf16x8){lo0[0], lo0[1], lo0[2], lo0[3], hi0[0], hi0[1], hi0[2], hi0[3]}, o[d0], 0, 0, 0);
    o[d0] = __builtin_amdgcn_mfma_f32_32x32x16_bf16(__builtin_bit_cast(bf16x8, pwB), (bf16x8){lo1[0], lo1[1], lo1[2], lo1[3], hi1[0], hi1[1], hi1[2], hi1[3]}, o[d0], 0, 0, 0);
  }
}
__device__ __forceinline__ void win_unit(int b, int h, int ld, int c, int I0, const bf16* QA, const bf16* KA, const bf16* VA, bf16* OA, float* LSE, lptr Lb, volatile __attribute__((address_space(3))) float* wsf, int lane, int wid) {
  const int r32 = lane & 31, hi = lane >> 5; const int L = 4096 >> ld; const long rowbase = (long)b * 4096;
  const bf16* Kc = KA + (rowbase + c) * 512 + h * 64; const bf16* Vc = VA + (rowbase + c) * 512 + h * 64;
  const unsigned lbase = (unsigned)(uintptr_t)Lb;
  for (int dupl_ = 0; dupl_ < ((PROBE_DUP & 4096) ? 2 : 1); ++dupl_) {
  if (dupl_) { WIN_WAITV0(); __syncthreads(); }
#pragma unroll
  for (int kt = 0; kt < 6; ++kt) { const int key = clampi(I0 - 64 + 64 * kt + lane, 0, L - 1);
    attn_body::glds16(Kc + ((long)key << ld) * 512 + wid * 8, (unsigned)__builtin_amdgcn_readfirstlane(lbase + kt * 8192 + wid * 1024)); }
#pragma unroll
  for (int kt = 0; kt < 6; ++kt) { const int key = clampi(I0 - 64 + 64 * kt + 16 * (wid & 3) + (lane >> 2), 0, L - 1);
    attn_body::glds16(Vc + ((long)key << ld) * 512 + (wid >> 2) * 32 + (lane & 3) * 8, (unsigned)__builtin_amdgcn_readfirstlane(lbase + 49152 + kt * 8192 + wid * 1024)); }
  }
  const int i0 = I0 + 32 * wid, qi = i0 + r32;
  const bf16* Qrow = QA + (rowbase + ((long)qi << ld) + c) * 512 + h * 64 + hi * 8;
  bf16x8 qr[4];
#pragma unroll
  for (int d0 = 0; d0 < 4; ++d0) qr[d0] = *reinterpret_cast<const bf16x8*>(Qrow + d0 * 16);
  f32x16 o[2]; o[0] = f32x16{}; o[1] = f32x16{}; float mrun = -1e30f, lrun = 0.f;
  const int vb0 = (int)lbase + 49152 + ((lane >> 4) & 1) * 32 + (lane & 3) * 8 + (4 * hi + ((lane & 15) >> 2)) * 64;
  WIN_WAITV0(); __syncthreads();
  const int tb = wid >> 1;
  f32x16 negm = f32x16{};
#define WIN_KF(kt_) bf16x8 kf[8]; { const lptr kp = Lb + (kt_) * 8192 + hi * 1024 + r32 * 16; _Pragma("unroll") for (int j = 0; j < 4; ++j) { kf[2 * j] = *(const __attribute__((address_space(3))) bf16x8*)(kp + j * 2048); kf[2 * j + 1] = *(const __attribute__((address_space(3))) bf16x8*)(kp + j * 2048 + 512); } }
  { const int kt = tb + 1; WIN_KF(kt) tile_step2<0>(kf, qr, o, negm, mrun, lrun, I0 - 64 + 64 * kt, qi, L, hi, r32, vb0 + kt * 8192, wsf); }
  if ((wid & 1) == 0) {
    { const int kt = tb;     WIN_KF(kt) tile_step2<1>(kf, qr, o, negm, mrun, lrun, I0 - 64 + 64 * kt, qi, L, hi, r32, vb0 + kt * 8192, wsf); }
    { const int kt = tb + 2; WIN_KF(kt) tile_half<0>(kf, qr, o, negm, mrun, lrun, I0 - 64 + 64 * kt, qi, L, hi, r32, vb0 + kt * 8192, wsf); }
  } else {
    { const int kt = tb;     WIN_KF(kt) tile_half<1>(kf, qr, o, negm, mrun, lrun, I0 - 64 + 64 * kt, qi, L, hi, r32, vb0 + kt * 8192, wsf); }
    { const int kt = tb + 2; WIN_KF(kt) tile_step2<2>(kf, qr, o, negm, mrun, lrun, I0 - 64 + 64 * kt, qi, L, hi, r32, vb0 + kt * 8192, wsf); }
  }
#undef WIN_KF
  { auto rr = __builtin_amdgcn_permlane32_swap(__float_as_uint(lrun), __float_as_uint(lrun), false, false); lrun = __uint_as_float(rr[0]) + __uint_as_float(rr[1]); }
  const long tok = rowbase + ((long)qi << ld) + c;
  if (hi == 0) { wsf[32 + r32] = lrun; LSE[tok * 8 + h] = mrun + __builtin_amdgcn_logf(lrun); }
  WIN_WAITL0();
  __attribute__((address_space(3))) unsigned short* stg = (__attribute__((address_space(3))) unsigned short*)(Lb + 98304 + wid * 4096);
#pragma unroll
  for (int r = 0; r < 16; ++r) { const int orow = attn_body::crow(r, hi); const float rl = __builtin_amdgcn_rcpf(wsf[32 + orow]);
#pragma unroll
    for (int d0 = 0; d0 < 2; ++d0) stg[orow * 64 + d0 * 32 + r32] = (unsigned short)(attn_body::cvtpk_s(o[d0][r] * rl, 0.f) & 0xffffu); }
  WIN_WAITL0();
#pragma unroll
  for (int i = 0; i < 4; ++i) { const int row = i * 8 + (lane >> 3), ch = lane & 7; const u32x4 v = *(const __attribute__((address_space(3))) u32x4*)(stg + row * 64 + ch * 8);
    *(u32x4*)(OA + (rowbase + ((long)(i0 + row) << ld) + c) * 512 + h * 64 + ch * 8) = v; }
  WIN_WAITL0(); __syncthreads();
}
struct WU { int b, h, ld, c, I0, p; };
__device__ __forceinline__ WU win_decode(int it) { WU w; const int blk = it & 15, rest = it >> 4; w.p = rest % 3; w.h = (rest / 3) & 7; w.b = rest / 24; w.ld = 2 * w.p; const int u = blk * 256; w.c = u >> (12 - w.ld); w.I0 = u & ((4096 >> w.ld) - 1); return w; }
__device__ __forceinline__ void win_issue(const WU& w, const bf16* QA, const bf16* KA, const bf16* VA, unsigned lbase, int lane, int wid, bf16x8* qr) {
  const int r32 = lane & 31, hi = lane >> 5; const int L = 4096 >> w.ld; const long rowbase = (long)w.b * 4096;
  const bf16* Kc = KA + (rowbase + w.c) * 512 + w.h * 64; const bf16* Vc = VA + (rowbase + w.c) * 512 + w.h * 64;
#pragma unroll
  for (int kt = 0; kt < 6; ++kt) { const int key = clampi(w.I0 - 64 + 64 * kt + lane, 0, L - 1);
    attn_body::glds16(Kc + ((long)key << w.ld) * 512 + wid * 8, (unsigned)__builtin_amdgcn_readfirstlane(lbase + kt * 8192 + wid * 1024)); }
#pragma unroll
  for (int kt = 0; kt < 6; ++kt) { const int key = clampi(w.I0 - 64 + 64 * kt + 16 * (wid & 3) + (lane >> 2), 0, L - 1);
    attn_body::glds16(Vc + ((long)key << w.ld) * 512 + (wid >> 2) * 32 + (lane & 3) * 8, (unsigned)__builtin_amdgcn_readfirstlane(lbase + 49152 + kt * 8192 + wid * 1024)); }
  const int qi = w.I0 + 32 * wid + r32;
  const bf16* Qrow = QA + (rowbase + ((long)qi << w.ld) + w.c) * 512 + w.h * 64 + hi * 8;
#pragma unroll
  for (int d0 = 0; d0 < 4; ++d0) qr[d0] = *reinterpret_cast<const bf16x8*>(Qrow + d0 * 16);
}
__device__ __forceinline__ void win_phase(int vcu, int G, int bx, const bf16* QA, const bf16* KA, const bf16* VA, bf16* OAb, float* LSEb, lptr Lb, volatile __attribute__((address_space(3))) float* wsf, int lane, int wid) {
  constexpr int NUN = 81920 / 256 * 8 * 3;
  const int r32 = lane & 31, hi = lane >> 5; const unsigned lbase = (unsigned)(uintptr_t)Lb;
  const bool g256 = (G == 256);
#define WIN_IT(i_) (g256 ? (((vcu >> 5) * 20 + 2 * ((i_) / 3)) * 48 + (vcu & 31) * 3 + ((i_) % 3)) : (bx + (i_) * G))
  int it = WIN_IT(0); if (it >= NUN) return;
  WU cur = win_decode(it); bf16x8 qr[4]; win_issue(cur, QA, KA, VA, lbase, lane, wid, qr);
  const int vb0 = (int)lbase + 49152 + ((lane >> 4) & 1) * 32 + (lane & 3) * 8 + (4 * hi + ((lane & 15) >> 2)) * 64;
  const int tb = wid >> 1;
  for (int i = 0;; ++i) {
    const int itn = WIN_IT(i + 1); const bool has_next = g256 ? (i + 1 < 30) : (itn < NUN);
    const int ld = cur.ld, L = 4096 >> ld, I0 = cur.I0; const long rowbase = (long)cur.b * 4096; const int i0 = I0 + 32 * wid, qi = i0 + r32;
    asm volatile("s_waitcnt vmcnt(0) lgkmcnt(0)" ::: "memory"); __builtin_amdgcn_s_barrier(); asm volatile("" ::: "memory");
    f32x16 o[2]; o[0] = f32x16{}; o[1] = f32x16{}; float mrun = -1e30f, lrun = 0.f; f32x16 negm = f32x16{};
#define WIN_KF(kt_) bf16x8 kf[8]; { const lptr kp = Lb + (kt_) * 8192 + hi * 1024 + r32 * 16; _Pragma("unroll") for (int j = 0; j < 4; ++j) { kf[2 * j] = *(const __attribute__((address_space(3))) bf16x8*)(kp + j * 2048); kf[2 * j + 1] = *(const __attribute__((address_space(3))) bf16x8*)(kp + j * 2048 + 512); } }
    { const int kt = tb + 1; WIN_KF(kt) tile_step2<0>(kf, qr, o, negm, mrun, lrun, I0 - 64 + 64 * kt, qi, L, hi, r32, vb0 + kt * 8192, wsf); }
    if ((wid & 1) == 0) {
      { const int kt = tb;     WIN_KF(kt) tile_step2<1>(kf, qr, o, negm, mrun, lrun, I0 - 64 + 64 * kt, qi, L, hi, r32, vb0 + kt * 8192, wsf); }
      { const int kt = tb + 2; WIN_KF(kt) tile_half<0>(kf, qr, o, negm, mrun, lrun, I0 - 64 + 64 * kt, qi, L, hi, r32, vb0 + kt * 8192, wsf); }
    } else {
      { const int kt = tb;     WIN_KF(kt) tile_half<1>(kf, qr, o, negm, mrun, lrun, I0 - 64 + 64 * kt, qi, L, hi, r32, vb0 + kt * 8192, wsf); }
      { const int kt = tb + 2; WIN_KF(kt) tile_step2<2>(kf, qr, o, negm, mrun, lrun, I0 - 64 + 64 * kt, qi, L, hi, r32, vb0 + kt * 8192, wsf); }
    }
#undef WIN_KF
    asm volatile("s_waitcnt lgkmcnt(0)" ::: "memory"); __builtin_amdgcn_s_barrier(); asm volatile("" ::: "memory");
    WU nxt = cur;
    if (has_next) { nxt = win_decode(itn); win_issue(nxt, QA, KA, VA, lbase, lane, wid, qr); }
    bf16* OA = OAb + (size_t)cur.p * 81920 * 512; float* LSE = LSEb + (size_t)cur.p * 81920 * 8; const int h = cur.h, c = cur.c;
    { auto rr = __builtin_amdgcn_permlane32_swap(__float_as_uint(lrun), __float_as_uint(lrun), false, false); lrun = __uint_as_float(rr[0]) + __uint_as_float(rr[1]); }
    const long tok = rowbase + ((long)qi << ld) + c;
    if (hi == 0) { wsf[32 + r32] = lrun; LSE[tok * 8 + h] = mrun + __builtin_amdgcn_logf(lrun); }
    WIN_WAITL0();
    __attribute__((address_space(3))) unsigned short* stg = (__attribute__((address_space(3))) unsigned short*)(Lb + 98304 + wid * 4096);
#pragma unroll
    for (int r = 0; r < 16; ++r) { const int orow = attn_body::crow(r, hi); const float rl = __builtin_amdgcn_rcpf(wsf[32 + orow]);
#pragma unroll
      for (int d0 = 0; d0 < 2; ++d0) stg[orow * 64 + d0 * 32 + r32] = (unsigned short)(attn_body::cvtpk_s(o[d0][r] * rl, 0.f) & 0xffffu); }
    WIN_WAITL0();
#pragma unroll
    for (int q = 0; q < 4; ++q) { const int row = q * 8 + (lane >> 3), ch = lane & 7; const u32x4 v = *(const __attribute__((address_space(3))) u32x4*)(stg + row * 64 + ch * 8);
      *(u32x4*)(OA + (rowbase + ((long)(i0 + row) << ld) + c) * 512 + h * 64 + ch * 8) = v; }
    WIN_WAITL0();
    if (!has_next) break;
    cur = nxt; it = itn;
  }
}
}

namespace cg = cooperative_groups;
using pg8::NSEQ; using pg8::SEQL; using pg8::TOK; using pg8::DM_; using pg8::NPROMPT_TOK; using pg8::ATTN_IN_W; using pg8::MiB; using pg8::WS_MOD; using pg8::WS_TAB; using pg8::WS_W; using pg8::WS_LSE; using pg8::WS_H; using pg8::WS_SG; using pg8::WS_QA; using pg8::WS_KA; using pg8::WS_VA; using pg8::WS_QB; using pg8::WS_KB; using pg8::WS_VB; using pg8::WS_OA; using pg8::WS_END; using pg8::WO_AIN; using pg8::WO_AOUT; using pg8::WO_PIN; using pg8::WO_GRP; using pg8::WO_POUT;
#define LAS __attribute__((address_space(3)))
typedef unsigned short bf16u;
typedef float f32x4 __attribute__((ext_vector_type(4)));
typedef unsigned v4u __attribute__((ext_vector_type(4)));
typedef unsigned v2u __attribute__((ext_vector_type(2)));
#define XB_TMO      128
#define XB_XCNT(j)  (256  + 64 * (j))
#define XB_XSUB(j)  (1280 + 64 * (j))
#define XB_XGEN(j)  (2304 + 64 * (j))
#define XB_TOP      3328
#define XB_TOPGEN   3392
#define XCD_BAR_WORDS 3456
#define XB_SPIN_CAP (1u << 18)

__device__ __forceinline__ unsigned xb_ld(unsigned* p)              { return __hip_atomic_load(p, __ATOMIC_RELAXED, __HIP_MEMORY_SCOPE_AGENT); }
__device__ __forceinline__ unsigned xb_add(unsigned* p, unsigned v) { return __hip_atomic_fetch_add(p, v, __ATOMIC_RELAXED, __HIP_MEMORY_SCOPE_AGENT); }
__device__ __forceinline__ unsigned xb_xcc_id() { return (unsigned)__builtin_amdgcn_s_getreg((3 << 11) | 20) & 0xFu; }
#define XB_SPIN(cond, bar) do { unsigned _sp = 0; while (cond) { __builtin_amdgcn_s_sleep(1); \
    if ((++_sp & 255u) == 0u) { if (xb_ld(&(bar)[XB_TMO])) break; if (_sp > XB_SPIN_CAP) { atomicAdd(&(bar)[XB_TMO], 1u); break; } } } } while (0)

struct XcdBarrier {
    unsigned* bar; unsigned x;
    volatile LAS unsigned* st;
};

__device__ __forceinline__ XcdBarrier xcd_barrier_post(unsigned* bar, volatile LAS unsigned* st) {
    XcdBarrier b; b.bar = bar; b.x = xb_xcc_id(); b.st = st;
    if (threadIdx.x == 0) (void)xb_add(&bar[XB_XCNT(b.x)], 1u);
    return b;
}
__device__ __forceinline__ void xcd_barrier_complete(unsigned* bar, unsigned x, unsigned& nloc, unsigned& nx) {
    const unsigned G = gridDim.x * gridDim.y * gridDim.z;
    unsigned sum, cnt, mine, sp = 0u;
    for (;;) {
        sum = 0u; cnt = 0u; mine = 0u;
#pragma unroll
        for (unsigned j = 0; j < 16; ++j) { const unsigned c = xb_ld(&bar[XB_XCNT(j)]); sum += c; cnt += (c > 0u) ? 1u : 0u; mine = (j == x) ? c : mine; }
        if (sum == G) break;
        __builtin_amdgcn_s_sleep(1);
        if ((++sp & 255u) == 0u) { if (xb_ld(&bar[XB_TMO])) break; if (sp > XB_SPIN_CAP) { atomicAdd(&bar[XB_TMO], 1u); break; } }
    }
    nloc = mine > 0u ? mine : 1u; nx = cnt > 0u ? cnt : 1u;
}

__device__ __forceinline__ void xcd_barrier(const XcdBarrier& b) {
    asm volatile("s_waitcnt vmcnt(0)" ::: "memory");
    __syncthreads();
    if (threadIdx.x == 0) {
        unsigned* bar = b.bar;
        __builtin_amdgcn_s_waitcnt(0);
        unsigned nloc = b.st[0], nx = b.st[1];
        if (nloc == 0u) { xcd_barrier_complete(bar, b.x, nloc, nx); b.st[0] = nloc; b.st[1] = nx; }
        const unsigned old = xb_add(&bar[XB_XSUB(b.x)], 1u);
        const unsigned gen = old / nloc;
        if (old + 1u == (gen + 1u) * nloc) {
            __builtin_amdgcn_fence(__ATOMIC_RELEASE, "agent");
            asm volatile("s_waitcnt vmcnt(0)" ::: "memory");
            const unsigned og = xb_add(&bar[XB_TOP], 1u);
            const unsigned tg = og / nx;
            if (og + 1u == (tg + 1u) * nx) xb_add(&bar[XB_TOPGEN], 1u);
            else XB_SPIN(xb_ld(&bar[XB_TOPGEN]) == tg, bar);
            __builtin_amdgcn_fence(__ATOMIC_ACQUIRE, "agent");
            xb_add(&bar[XB_XGEN(b.x)], 1u);
            asm volatile("s_waitcnt vmcnt(0)" ::: "memory");
        } else {
            XB_SPIN(xb_ld(&bar[XB_XGEN(b.x)]) == gen, bar);
            __builtin_amdgcn_fence(__ATOMIC_ACQUIRE, "agent");
            asm volatile("s_waitcnt vmcnt(0)" ::: "memory");
        }
    }
    __syncthreads();
}

constexpr int RING_BYTES = 131072, LDS_BYTES = 147456, WSF_OFF = RING_BYTES + 512, BARLDS_OFF = WSF_OFF + 8 * 256;
constexpr size_t WS_BAR = WS_MOD + 983040;

__device__ __forceinline__ unsigned f2bf(float f) { unsigned u = __builtin_bit_cast(unsigned, f); return (u + 0x7fffu + ((u >> 16) & 1u)) >> 16; }
__device__ __forceinline__ unsigned pk2(float lo, float hi) { return f2bf(lo) | (f2bf(hi) << 16); }
__device__ __forceinline__ float bflo(unsigned w) { return __uint_as_float(w << 16); }
__device__ __forceinline__ float bfhi(unsigned w) { return __uint_as_float(w & 0xffff0000u); }
__device__ __forceinline__ int opq(int x) { asm volatile("" : "+v"(x)); return x; }
__device__ __forceinline__ float wave_sum(float v) {
#pragma unroll
  for (int o = 1; o < 64; o <<= 1) v += __shfl_xor(v, o);
  return v;
}
__device__ __forceinline__ void transpose_item(const float* W, int K, int N, bf16u* WT, int row_off, LAS float* scr, int item, int lane, bool perm) {
  const int nblk = N / 32, kb = item / nblk, nb = item % nblk, k0 = 64 * kb, n0 = 32 * nb;
#pragma unroll 8
  for (int i = 0; i < 32; ++i) { const int kk = 2 * i + (lane >> 5); scr[kk * 33 + (lane & 31)] = W[(size_t)(k0 + kk) * N + n0 + (lane & 31)]; }
  asm volatile("s_waitcnt lgkmcnt(0)" ::: "memory");
  const int c = lane & 7;
  const int n0d = perm ? ((n0 & ~255) + 128 * ((n0 >> 5) & 1) + 32 * ((n0 >> 6) & 3)) : n0;
#pragma unroll
  for (int j = 0; j < 4; ++j) { const int n = (lane >> 3) + 8 * j; const LAS float* s = scr + (8 * c) * 33 + n;
    v4u o; o.x = pk2(s[0 * 33], s[1 * 33]); o.y = pk2(s[2 * 33], s[3 * 33]); o.z = pk2(s[4 * 33], s[5 * 33]); o.w = pk2(s[6 * 33], s[7 * 33]);
    *(v4u*)(WT + (size_t)(row_off + n0d + n) * K + k0 + 8 * c) = o; }
  asm volatile("s_waitcnt lgkmcnt(0)" ::: "memory");
}
__device__ __forceinline__ void prenorm_store(const f32x4 (&v)[4], const float* pre, const float* mod, bf16u* hrow, int lane) {
  float ss = 0.f;
#pragma unroll
  for (int j = 0; j < 4; ++j) ss += (v[j].x * v[j].x + v[j].y * v[j].y) + (v[j].z * v[j].z + v[j].w * v[j].w);
  const float rinv = rsqrtf(wave_sum(ss) * (1.f / 1024.f) + 1e-6f);
#pragma unroll
  for (int j = 0; j < 4; ++j) { const int c = 256 * j + 4 * lane; const f32x4 g = *(const f32x4*)(pre + c), sh = *(const f32x4*)(mod + c), sc = *(const f32x4*)(mod + 1024 + c);
    const f32x4 hval = v[j] * rinv * g * (sc + 1.f) + sh; v2u o; o.x = pk2(hval.x, hval.y); o.y = pk2(hval.z, hval.w); *(v2u*)(hrow + c) = o; }
}

__device__ __forceinline__ void post_phase(int l, bool do_next, const float* x_p, const float* x_s, float* out, const bf16u* Mo, const float* MOD, const float* post_norm, const float* pre_norm, bf16u* H, int gw, int NGW, int lane) {
  const int wpb = NGW / NSEQ; if (gw >= wpb * NSEQ) return;
  const int b = gw / wpb, j0 = gw - b * wpb;
  f32x4 gp[4], g1[4], sh[4];
  { const float* md = MOD + ((size_t)l * NSEQ + b) * 3072; const float* mn = MOD + ((size_t)(l + 1) * NSEQ + b) * 3072;
#pragma unroll
    for (int j = 0; j < 4; ++j) { const int c = 256 * j + 4 * lane; gp[j] = *(const f32x4*)(post_norm + l * 1024 + c) * *(const f32x4*)(md + 2048 + c);
      if (do_next) { g1[j] = *(const f32x4*)(pre_norm + (l + 1) * 1024 + c) * (*(const f32x4*)(mn + 1024 + c) + 1.f); sh[j] = *(const f32x4*)(mn + c); } else { g1[j] = (f32x4){0.f, 0.f, 0.f, 0.f}; sh[j] = g1[j]; } } }
#define POST_LOAD(XV, MW, R0) do { const int mA_ = b * SEQL + (R0), mB_ = ((R0) + wpb) < SEQL ? mA_ + wpb : mA_; \
    _Pragma("unroll") for (int r = 0; r < 2; ++r) { const int m = r ? mB_ : mA_; const float* xr = (l == 0) ? ((m < NPROMPT_TOK) ? x_p + (size_t)m * 1024 : x_s + (size_t)(m - NPROMPT_TOK) * 1024) : out + (size_t)m * 1024; \
      _Pragma("unroll") for (int j = 0; j < 4; ++j) { XV[r][j] = *(const f32x4*)(xr + 256 * j + 4 * lane); MW[r][j] = *(const v2u*)(Mo + (size_t)m * 1024 + 256 * j + 4 * lane); } } } while (0)
  f32x4 xv[2][4]; v2u mw[2][4];
  if (j0 < SEQL) POST_LOAD(xv, mw, j0);
  for (int r0 = j0; r0 < SEQL; r0 += 2 * wpb) {
    const bool ok1 = (r0 + wpb) < SEQL; const int mA = b * SEQL + r0, mB = ok1 ? mA + wpb : mA;
    f32x4 xn_[2][4]; v2u mn_[2][4]; const int rn = r0 + 2 * wpb; const bool more = rn < SEQL;
    if (more) POST_LOAD(xn_, mn_, rn);
#pragma unroll
    for (int r = 0; r < 2; ++r) { const int m = r ? mB : mA; f32x4 mv[4]; float ss = 0.f;
#pragma unroll
      for (int j = 0; j < 4; ++j) { const v2u w = mw[r][j]; mv[j] = (f32x4){bflo(w.x), bfhi(w.x), bflo(w.y), bfhi(w.y)}; ss += (mv[j].x * mv[j].x + mv[j].y * mv[j].y) + (mv[j].z * mv[j].z + mv[j].w * mv[j].w); }
      const float rinv = rsqrtf(wave_sum(ss) * (1.f / 1024.f) + 1e-6f);
      if (r == 0 || ok1) {
        float s2 = 0.f;
#pragma unroll
        for (int j = 0; j < 4; ++j) { const int c = 256 * j + 4 * lane; const f32x4 xn = xv[r][j] + gp[j] * (mv[j] * rinv); xv[r][j] = xn; *(f32x4*)(out + (size_t)m * 1024 + c) = xn;
          s2 += (xn.x * xn.x + xn.y * xn.y) + (xn.z * xn.z + xn.w * xn.w); }
        if (do_next) { const float r2 = rsqrtf(wave_sum(s2) * (1.f / 1024.f) + 1e-6f);
#pragma unroll
          for (int j = 0; j < 4; ++j) { const int c = 256 * j + 4 * lane; const f32x4 hval = xv[r][j] * r2 * g1[j] + sh[j]; v2u o; o.x = pk2(hval.x, hval.y); o.y = pk2(hval.z, hval.w); *(v2u*)(H + (size_t)m * 1024 + c) = o; } }
      }
    }
    if (more) {
#pragma unroll
      for (int r = 0; r < 2; ++r)
#pragma unroll
        for (int j = 0; j < 4; ++j) { xv[r][j] = xn_[r][j]; mw[r][j] = mn_[r][j]; } }
  }
#undef POST_LOAD
}
#define PH_VARS \
  ArgsP ap = argp(); unsigned char* ws = GPTR(unsigned char, ap->ws); float* out = GPTR(float, ap->out); (void)out; \
  const float *x_p = GPTR(const float, ap->in[0]), *x_s = GPTR(const float, ap->in[1]), *c_p = GPTR(const float, ap->in[2]), *c_s = GPTR(const float, ap->in[3]), *ada_w = GPTR(const float, ap->in[4]), *ada_b = GPTR(const float, ap->in[5]), *pre_norm = GPTR(const float, ap->in[6]), *post_norm = GPTR(const float, ap->in[7]), *attn_w_in = GPTR(const float, ap->in[8]), *attn_qn = GPTR(const float, ap->in[9]), *attn_kn = GPTR(const float, ap->in[10]), \
              *attn_w_out = GPTR(const float, ap->in[11]), *pool_w_in = GPTR(const float, ap->in[12]), *pool_w_grp = GPTR(const float, ap->in[13]), *pool_scale = GPTR(const float, ap->in[14]), *pool_w_out = GPTR(const float, ap->in[15]); \
  (void)x_p; (void)x_s; (void)c_p; (void)c_s; (void)ada_w; (void)ada_b; (void)pre_norm; (void)post_norm; (void)attn_w_in; (void)attn_qn; (void)attn_kn; (void)attn_w_out; (void)pool_w_in; (void)pool_w_grp; (void)pool_scale; (void)pool_w_out; \
  float* ropeA = (float*)(ws + WS_TAB); float* ropeX = ropeA + 4096 * 16; float* MOD = (float*)(ws + WS_MOD); (void)ropeX; (void)MOD; \
  bf16u* Wb = (bf16u*)(ws + WS_W); (void)Wb; \
  bf16u *H = (bf16u*)(ws + WS_H), *SG = (bf16u*)(ws + WS_SG), *QA = (bf16u*)(ws + WS_QA), *KA = (bf16u*)(ws + WS_KA), *VA = (bf16u*)(ws + WS_VA), *QB = (bf16u*)(ws + WS_QB), *KB = (bf16u*)(ws + WS_KB), *VB = (bf16u*)(ws + WS_VB), \
        *OA = (bf16u*)(ws + WS_OA); \
  bf16u *Y = H, *Mo = QA, *U = QA, *PO = VA; float* LSE = (float*)(ws + WS_LSE); \
  (void)H; (void)SG; (void)QA; (void)KA; (void)VA; (void)QB; (void)KB; (void)VB; (void)OA; (void)Y; (void)Mo; (void)U; (void)PO; (void)LSE;

__global__ void __launch_bounds__(512, 2) fwd_mega(Args a) {
  extern __shared__ __attribute__((aligned(16))) unsigned char lds[];
  cg::grid_group grid = cg::this_grid();
  const int tid = threadIdx.x, lane = tid & 63, wave = __builtin_amdgcn_readfirstlane(tid >> 6);
  const int G = gridDim.x, bx = blockIdx.x; const int vcu = (G % 8 == 0) ? (bx % 8) * (G / 8) + bx / 8 : bx;
  const int gw = vcu * 8 + wave, NGW = G * 8;
  LAS unsigned char* L = (LAS unsigned char*)lds;
  if (tid < 2) ((volatile LAS unsigned*)(L + BARLDS_OFF))[tid] = 0u;
  __syncthreads();
  { ArgsP ap0 = argp(); (void)xcd_barrier_post((unsigned*)(GPTR(unsigned char, ap0->ws) + WS_BAR), (volatile LAS unsigned*)(L + BARLDS_OFF)); }
#define GRID_BAR() do { ArgsP apb = argp(); XcdBarrier xb_; xb_.bar = (unsigned*)(GPTR(unsigned char, apb->ws) + WS_BAR); xb_.x = xb_xcc_id(); xb_.st = (volatile LAS unsigned*)(L + BARLDS_OFF); xcd_barrier(xb_); } while (0)

  {
    PH_VARS
    LAS float* scr = (LAS float*)(L + wave * 16384);
    constexpr int I_AIN = 16 * 104, I_AOUT = 16 * 32, I_PIN = 16 * 64, I_GRP = 4 * 8, I_POUT = 16 * 32;
    constexpr int NIT = 2 * I_AIN + 2 * I_AOUT + 2 * I_PIN + 8 * I_GRP + 2 * I_POUT;
    for (int dup_ = 0; dup_ < ((PROBE_DUP & 1024) ? 2 : 1); ++dup_)
    for (int it = gw; it < NIT; it += NGW) {
      int r = it;
      if (r < 2 * I_AIN) { const int i = r / I_AIN; transpose_item(attn_w_in + (size_t)i * 1024 * 3328, 1024, 3328, Wb + WO_AIN + (size_t)i * 3328 * 1024, 0, scr, r % I_AIN, lane, true); continue; } r -= 2 * I_AIN;
      if (r < 2 * I_AOUT) { const int i = r / I_AOUT; transpose_item(attn_w_out + (size_t)i * 1024 * 1024, 1024, 1024, Wb + WO_AOUT + (size_t)i * 1024 * 1024, 0, scr, r % I_AOUT, lane, false); continue; } r -= 2 * I_AOUT;
      if (r < 2 * I_PIN) { const int i = r / I_PIN; transpose_item(pool_w_in + (size_t)i * 1024 * 2048, 1024, 2048, Wb + WO_PIN + (size_t)i * 2048 * 1024, 0, scr, r % I_PIN, lane, false); continue; } r -= 2 * I_PIN;
      if (r < 8 * I_GRP) { const int ig = r / I_GRP; transpose_item(pool_w_grp + (size_t)ig * 65536, 256, 256, Wb + WO_GRP + (size_t)(ig >> 2) * 262144, (ig & 3) * 256, scr, r % I_GRP, lane, false); continue; } r -= 8 * I_GRP;
      { const int i = r / I_POUT; transpose_item(pool_w_out + (size_t)i * 1024 * 1024, 1024, 1024, Wb + WO_POUT + (size_t)i * 1024 * 1024, 0, scr, r % I_POUT, lane, false); }
    }
    for (int e = bx * 512 + tid; e < 4096 * 8 + 64 * 16; e += G * 512) {
      int pos, j; double inv; float* dstc; float* dsts;
      if (e < 4096 * 8) { pos = e >> 3; j = e & 7; inv = ap->invA[j]; dstc = ropeA + pos * 16 + j; dsts = dstc + 8; }
      else { const int f = e - 4096 * 8; pos = f >> 4; j = f & 15; inv = ap->invX[j]; dstc = ropeX + pos * 32 + j; dsts = dstc + 16; }
      const double rev = (double)pos * inv * 0.15915494309189535; const float fr = (float)(rev - __builtin_rint(rev));
      *dstc = __builtin_amdgcn_cosf(fr); *dsts = __builtin_amdgcn_sinf(fr);
    }
    { LAS float* sc = (LAS float*)(L + wave * 16384); const int kc = wave;
#pragma unroll
      for (int b = 0; b < NSEQ; ++b)
#pragma unroll
        for (int q = 0; q < 2; ++q) { const int kk = kc * 128 + q * 64 + lane; const float cv = (b < 16) ? c_p[b * 1024 + kk] : c_s[(b - 16) * 1024 + kk]; sc[b * 128 + q * 64 + lane] = pg8::silu_f(cv); }
      asm volatile("s_waitcnt lgkmcnt(0)" ::: "memory");
      for (int it = gw; it < 4 * 48 * 8; it += NGW) {
        const int nbk = (it >> 3) % 48, l = it / 384; const int n = nbk * 64 + lane;
        float acc[NSEQ];
#pragma unroll
        for (int b = 0; b < NSEQ; ++b) acc[b] = 0.f;
        const float* wp = ada_w + ((size_t)l * 1024 + kc * 128) * 3072 + n;
#pragma unroll 16
        for (int k = 0; k < 128; ++k) { const float w = wp[(size_t)k * 3072];
#pragma unroll
          for (int b = 0; b < NSEQ; ++b) acc[b] += sc[b * 128 + k] * w; }
        const float bias = (kc == 0) ? ada_b[l * 3072 + n] : 0.f;
#pragma unroll
        for (int b = 0; b < NSEQ; ++b) atomicAdd(MOD + ((size_t)l * NSEQ + b) * 3072 + n, acc[b] + bias);
      }
    }
  }
  grid.sync();
  if (PROBE_DUP & 2048) { for (int q = 0; q < 20; ++q) GRID_BAR(); }
  for (int dup_ = 0; dup_ < ((PROBE_DUP & 512) ? 2 : 1); ++dup_) { PH_VARS
  for (int m0 = gw; m0 < TOK; m0 += 2 * NGW) {
    const bool ok1 = (m0 + NGW) < TOK; f32x4 v[2][4];
#pragma unroll
    for (int r = 0; r < 2; ++r) { const int m = (r && ok1) ? m0 + NGW : m0; const float* xr = (m < NPROMPT_TOK) ? x_p + (size_t)m * 1024 : x_s + (size_t)(m - NPROMPT_TOK) * 1024;
#pragma unroll
      for (int j = 0; j < 4; ++j) v[r][j] = *(const f32x4*)(xr + 256 * j + 4 * lane); }
#pragma unroll
    for (int r = 0; r < 2; ++r) { const int m = (r && ok1) ? m0 + NGW : m0; if (r == 0 || ok1) prenorm_store(v[r], pre_norm, MOD + (size_t)(m >> 12) * 3072, H + (size_t)m * 1024, lane); }
  } }
  GRID_BAR();

  for (int li = 0; li < 2; ++li) {
    {
      const int l = 2 * li;
      for (int dup_ = 0; dup_ < ((PROBE_DUP & 8) ? 2 : 1); ++dup_) { PH_VARS pg8::EpiP EP{li}; pg8::Gemm g{H, Wb + WO_AIN + (size_t)li * 3328 * 1024, TOK, ATTN_IN_W, 1024, 1024, 0}; pg8::StaticOrder S; S.init(TOK, ATTN_IN_W, G, bx);

#ifndef NO_G0
pg8::Epi<0> E{EP}; pg8::gemm_phase<pg8::Epi<0>, pg8::StaticOrder, true, true>(L, g, S, E);
#endif
 }
      GRID_BAR();
      for (int dup_ = 0; dup_ < ((PROBE_DUP & 1) ? 2 : 1); ++dup_) { PH_VARS const int nun = NSEQ * 8 * 16;
        { attn_body::bf16x8 qio[4]; bool pre = false;
        for (int i = 0;; ++i) {
          int b, h, qb, nb = 0, nh = 0, nqb = 0; bool has_next;
          if (G == 256) { if (i >= 10) break; const int xc = vcu >> 5, j = vcu & 31, pair = xc * 5 + (i >> 1), uip = (i & 1) * 32 + j; b = pair >> 1; h = (pair & 1) * 4 + (uip >> 4); qb = uip & 15;
            has_next = (i + 1 < 10); { const int i2 = i + 1, pair2 = xc * 5 + (i2 >> 1), uip2 = (i2 & 1) * 32 + j; nb = pair2 >> 1; nh = (pair2 & 1) * 4 + (uip2 >> 4); nqb = uip2 & 15; } }
          else { const int n = i * G + bx; if (n >= nun) break; b = n >> 7; h = (n >> 4) & 7; qb = n & 15; const int n2 = n + G; has_next = n2 < nun; nb = n2 >> 7; nh = (n2 >> 4) & 7; nqb = n2 & 15; }
#ifndef NO_DENSE
          attn_body::attn_unit<8>(b, h, qb, (const attn_body::bf16*)QB, (const attn_body::bf16*)KB, (const attn_body::bf16*)VB, (attn_body::bf16*)Y, (const attn_body::bf16*)SG, (char*)lds, pre, qio, has_next, nb, nh, nqb);
#endif
          pre = has_next;
        } }
      }
      __syncthreads();
      for (int dup_ = 0; dup_ < ((PROBE_DUP & 2) ? 2 : 1); ++dup_) { PH_VARS const int lane = opq(tid) & 63; win::lptr wl = (win::lptr)(L + wave * 16384); volatile LAS float* wsf = (volatile LAS float*)(L + WSF_OFF + wave * 256);
        win::win_phase(vcu, G, bx, (const win::bf16*)QA, (const win::bf16*)KA, (const win::bf16*)VA, (win::bf16*)OA, LSE, (win::lptr)L, wsf, lane, wave);
      }
      GRID_BAR();
      for (int dup_ = 0; dup_ < ((PROBE_DUP & 4) ? 2 : 1); ++dup_) { PH_VARS
      for (int m0 = gw; m0 < TOK; m0 += 2 * NGW) {
        const int lane = opq(tid) & 63; const int hh = lane >> 3; const bool ok1 = (m0 + NGW) < TOK;
        float ls[2][3]; v4u ov[2][3]; v4u gv[2];
#pragma unroll
        for (int r = 0; r < 2; ++r) { const int m = (r && ok1) ? m0 + NGW : m0;
#pragma unroll
          for (int p = 0; p < 3; ++p) { ls[r][p] = LSE[((size_t)p * TOK + m) * 8 + hh]; ov[r][p] = *(const v4u*)(OA + ((size_t)p * TOK + m) * 512 + 8 * lane); }
          gv[r] = *(const v4u*)(SG + (size_t)m * 1024 + 8 * lane); }
#pragma unroll
        for (int r = 0; r < 2; ++r) { const int m = (r && ok1) ? m0 + NGW : m0;
          const float mx = fmaxf(fmaxf(ls[r][0], ls[r][1]), ls[r][2]); float wsum = 0.f;
#pragma unroll
          for (int p = 0; p < 3; ++p) { ls[r][p] = __builtin_amdgcn_exp2f(ls[r][p] - mx); wsum += ls[r][p]; }
          const float rw = 1.f / wsum; float accv[8];
#pragma unroll
          for (int j = 0; j < 8; ++j) accv[j] = 0.f;
#pragma unroll
          for (int p = 0; p < 3; ++p) { const float wgt = ls[r][p] * rw;
#pragma unroll
            for (int q = 0; q < 4; ++q) { accv[2 * q] += wgt * bflo(ov[r][p][q]); accv[2 * q + 1] += wgt * bfhi(ov[r][p][q]); } }
          v4u o;
#pragma unroll
          for (int q = 0; q < 4; ++q) o[q] = pk2(accv[2 * q] * bflo(gv[r][q]), accv[2 * q + 1] * bfhi(gv[r][q]));
          if (r == 0 || ok1) *(v4u*)(Y + (size_t)m * 1024 + 8 * lane) = o;
        }
      } }
      GRID_BAR();
      for (int dup_ = 0; dup_ < ((PROBE_DUP & 32) ? 2 : 1); ++dup_) { PH_VARS pg8::EpiP EP{li}; pg8::Gemm g{Y, Wb + WO_AOUT + (size_t)li * 1024 * 1024, TOK, 1024, 1024, 1024, 0}; pg8::StaticOrder S; S.init(TOK, 1024, G, bx);

#ifndef NO_G3
pg8::Epi<3> E{EP}; pg8::gemm_phase<pg8::Epi<3>, pg8::StaticOrder, true, true>(L, g, S, E);
#endif
 }
      GRID_BAR();
      { PH_VARS
      { const int lane = opq(tid) & 63; post_phase(l, true, x_p, x_s, out, Mo, MOD, post_norm, pre_norm, H, gw, NGW, lane); } }
      GRID_BAR();
    }
    {
      const int l = 2 * li + 1;
      for (int dup_ = 0; dup_ < ((PROBE_DUP & 16) ? 2 : 1); ++dup_) { PH_VARS pg8::EpiP EP{li}; pg8::Gemm g{H, Wb + WO_PIN + (size_t)li * 2048 * 1024, TOK, 2048, 1024, 1024, 0}; pg8::StaticOrder S; S.init(TOK, 2048, G, bx);

#ifndef NO_G1
pg8::Epi<1> E{EP}; pg8::gemm_phase<pg8::Epi<1>, pg8::StaticOrder, true, true>(L, g, S, E);
#endif
 }
      GRID_BAR();
      for (int dup_ = 0; dup_ < ((PROBE_DUP & 256) ? 2 : 1); ++dup_) { PH_VARS
      for (int it = gw; it < TOK / 16 * 4; it += NGW) {
        const int lane = opq(tid) & 63; const int gidx = it & 3, m0 = (it >> 2) * 16 + 8 * (lane >> 5), t0 = m0 & 4095, ch = gidx * 32 + (lane & 31);
        const bf16u* base = U + (size_t)(m0 - t0) * 1024 + 8 * ch; bf16u* dstp = PO + (size_t)m0 * 1024 + 8 * ch;
#define POOL_BODY(HALF) { v4u w[8 + 2 * HALF]; \
          _Pragma("unroll") for (int d = 0; d < 8 + 2 * HALF; ++d) { int tt = t0 - HALF + d; tt = tt < 0 ? 0 : (tt > 4095 ? 4095 : tt); w[d] = *(const v4u*)(base + (size_t)tt * 1024); } \
          float s[8]; _Pragma("unroll") for (int j = 0; j < 8; ++j) s[j] = 0.f; \
          _Pragma("unroll") for (int d = 0; d < 2 * HALF; ++d) { const int tt = t0 - HALF + d; const float f = (tt >= 0 && tt < 4096) ? 1.f : 0.f; \
            _Pragma("unroll") for (int j = 0; j < 4; ++j) { s[2 * j] += f * bflo(w[d][j]); s[2 * j + 1] += f * bfhi(w[d][j]); } } \
          _Pragma("unroll") for (int i = 0; i < 8; ++i) { const int t = t0 + i; const int lo = (t - HALF) < 0 ? 0 : t - HALF, hi2 = (t + HALF) > 4096 ? 4096 : t + HALF; const float rc = 1.f / (float)(hi2 - lo); \
            const v4u uw = w[i + HALF]; v4u o; \
            _Pragma("unroll") for (int j = 0; j < 4; ++j) o[j] = pk2(s[2 * j] * rc - bflo(uw[j]), s[2 * j + 1] * rc - bfhi(uw[j])); \
            *(v4u*)(dstp + (size_t)i * 1024) = o; \
            if (i < 7) { const int ta = t + HALF + 0, tb = t - HALF; const float fa = (ta < 4096) ? 1.f : 0.f, fb = (tb >= 0) ? 1.f : 0.f; \
              _Pragma("unroll") for (int j = 0; j < 4; ++j) { s[2 * j] += fa * bflo(w[i + 2 * HALF][j]) - fb * bflo(w[i][j]); s[2 * j + 1] += fa * bfhi(w[i + 2 * HALF][j]) - fb * bfhi(w[i][j]); } } } }
        if (gidx == 0) POOL_BODY(1) else if (gidx == 1) POOL_BODY(2) else if (gidx == 2) POOL_BODY(4) else POOL_BODY(8)
#undef POOL_BODY
      } }
      GRID_BAR();
      for (int dup_ = 0; dup_ < ((PROBE_DUP & 64) ? 2 : 1); ++dup_) { PH_VARS pg8::EpiP EP{li}; pg8::Gemm g{PO, Wb + WO_GRP + (size_t)li * 262144, TOK, 1024, 256, 1024, 512}; pg8::StaticOrder S; S.init(TOK, 1024, G, bx);

#ifndef NO_G2
pg8::Epi<2> E{EP}; pg8::gemm_phase<pg8::Epi<2>, pg8::StaticOrder, true, true>(L, g, S, E);
#endif
 }
      GRID_BAR();
      for (int dup_ = 0; dup_ < ((PROBE_DUP & 32) ? 2 : 1); ++dup_) { PH_VARS pg8::EpiP EP{li}; pg8::Gemm g{Y, Wb + WO_POUT + (size_t)li * 1024 * 1024, TOK, 1024, 1024, 1024, 0}; pg8::StaticOrder S; S.init(TOK, 1024, G, bx);

#ifndef NO_G3
pg8::Epi<3> E{EP}; pg8::gemm_phase<pg8::Epi<3>, pg8::StaticOrder, true, true>(L, g, S, E);
#endif
 }
      GRID_BAR();
      { PH_VARS
      { const int lane = opq(tid) & 63; post_phase(l, l < 3, x_p, x_s, out, Mo, MOD, post_norm, pre_norm, H, gw, NGW, lane); } }
      if (l < 3) GRID_BAR();
    }
  }
}

extern "C" void kernel_launch(void* const* d_in, const int* in_sizes, int n_in, void* d_out, int out_size, void* d_ws, size_t ws_size, hipStream_t stream) {
  static int grid = 0;
  if (grid == 0) {
    if (n_in != 16 || out_size != TOK * 1024 || ws_size < WS_END) { fprintf(stderr, "kernel_launch: unexpected shapes (n_in %d out %d ws %zu)\n", n_in, out_size, ws_size); grid = -1; return; }
    int dev = 0, cus = 0, per_cu = 0;
    if (hipGetDevice(&dev) != hipSuccess || hipDeviceGetAttribute(&cus, hipDeviceAttributeMultiprocessorCount, dev) != hipSuccess) { grid = -1; return; }
    if (hipFuncSetAttribute((const void*)fwd_mega, hipFuncAttributeMaxDynamicSharedMemorySize, LDS_BYTES) != hipSuccess) { fprintf(stderr, "kernel_launch: hipFuncSetAttribute failed\n"); grid = -1; return; }
    if (hipOccupancyMaxActiveBlocksPerMultiprocessor(&per_cu, (const void*)fwd_mega, 512, LDS_BYTES) != hipSuccess || per_cu < 1) { fprintf(stderr, "kernel_launch: occupancy query %d\n", per_cu); per_cu = 1; }
    (void)hipGetLastError();
    grid = cus * 1;
  }
  if (grid < 0) return;
  (void)hipMemsetAsync((char*)d_ws + WS_MOD, 0, 1 * MiB, stream);
  Args a{};
  for (int i = 0; i < 16; ++i) a.in[i] = (const float*)d_in[i];
  a.out = (float*)d_out; a.ws = (unsigned char*)d_ws;
  for (int j = 0; j < 8; ++j) a.invA[j] = pow(500000.0, -(double)j / 8.0);
  for (int j = 0; j < 16; ++j) a.invX[j] = pow(10000.0, -(double)j / 16.0);
  void* args[] = {&a};
  hipError_t e = hipLaunchCooperativeKernel((const void*)fwd_mega, dim3(grid), dim3(512), args, LDS_BYTES, stream);
  if (e != hipSuccess) fprintf(stderr, "cooperative launch failed: %s (grid %d)\n", hipGetErrorString(e), grid);
}
```

```cpp
#ifndef PROBE_DUP
#define PROBE_DUP 0
#endif
#include <hip/hip_cooperative_groups.h>
#include <cmath>
#include <hip/hip_runtime.h>
#include <cstdio>
#include <cstdint>
#define GPTR(T, x) ((T*)(__attribute__((address_space(1))) T*)(x))
struct Args { const float* in[16]; float* out; unsigned char* ws; double invA[8]; double invX[16]; };
typedef const __attribute__((address_space(4))) Args* ArgsP;
__device__ __forceinline__ ArgsP argp() { ArgsP p = (ArgsP)__builtin_amdgcn_kernarg_segment_ptr(); asm volatile("" : "+s"(p)); return p; }
__device__ __forceinline__ const char* uni_ptr(const char* p) { const unsigned long long v = (unsigned long long)p; const unsigned lo = __builtin_amdgcn_readfirstlane((unsigned)v), hi = __builtin_amdgcn_readfirstlane((unsigned)(v >> 32)); return (const char*)(((unsigned long long)hi << 32) | lo); }
namespace pg8 {
#define PG8_LAS __attribute__((address_space(3)))
typedef unsigned short bf16_t;
typedef short bf16x8 __attribute__((ext_vector_type(8)));
typedef float f32x4 __attribute__((ext_vector_type(4)));
typedef unsigned u32x4 __attribute__((ext_vector_type(4)));
constexpr int BM = 256, BK = 64, HALF = 128, HTB = HALF * BK * 2  , STAGE_BYTES = 8 * HTB, NXCD = 8, WGM = 8;

__host__ __device__ __forceinline__ int lds_byte(int r, int c) { const int st = (r >> 4) * 2 + (c >> 5), rr = r & 15, cc = c & 31, ob = rr * 64 + cc * 2; return st * 1024 + (ob ^ (((ob >> 9) & 1) << 5)); }
__host__ __device__ __forceinline__ void stage_rc(int b, int& R, int& C) { const int st = b / 1024, sb = b % 1024, swz = sb ^ (((sb >> 9) & 1) << 5); R = (st >> 1) * 16 + swz / 64; C = (st & 1) * 32 + (swz % 64) / 2; }
__host__ __device__ __forceinline__ int perm32(int rho) { const int n = rho >> 4, i = rho & 15; return 8 * (i >> 2) + 4 * n + (i & 3); }

struct Unit { int pm, pn; };
struct Gemm { const bf16_t* A; const bf16_t* Bt; int M, N, K; int lda; int a_pn_bytes; };

struct StaticOrder {
    int nM, nN, nwg, G, c;
    __host__ __device__ void init(int M, int N, int G_, int c_) { nM = M / BM; nN = N / BM; nwg = nM * nN; G = G_; c = c_; }
    __host__ __device__ bool next(int i, Unit& u) const {
        const long L = (long)i * G + c; if (L >= nwg) return false;
        int wgid = (int)L; { const int q = nwg / NXCD, r = nwg % NXCD, xcd = wgid % NXCD, off = wgid / NXCD; wgid = (xcd < r ? xcd * (q + 1) : r * (q + 1) + (xcd - r) * q) + off; }
        const int nig = WGM * nN, gid = wgid / nig, fm = gid * WGM, gsz = (nM - fm) < WGM ? (nM - fm) : WGM;
        u.pm = fm + ((wgid % nig) % gsz); u.pn = (wgid % nig) / gsz; return true;
    }
    __device__ __forceinline__ void a_ready(const Unit&) const {}
    __device__ __forceinline__ void done(const Unit&) const {}
};

__device__ __forceinline__ unsigned cvt_pk_bf16(float lo, float hi) { unsigned r; asm volatile("v_cvt_pk_bf16_f32 %0, %1, %2" : "=v"(r) : "v"(lo), "v"(hi)); return r; }
typedef float f32x2 __attribute__((ext_vector_type(2)));
constexpr int NSEQ = 20, SEQL = 4096, TOK = NSEQ * SEQL, DM_ = 1024, NPROMPT_TOK = 16 * 4096, ATTN_IN_W = 3328;
constexpr size_t MiB = 1u << 20;
constexpr size_t WS_MOD = 1 * MiB, WS_TAB = 0  , WS_W = 2 * MiB, WS_LSE = 34 * MiB, WS_H = 44 * MiB, WS_SG = 204 * MiB, WS_QA = 364 * MiB, WS_KA = 444 * MiB, WS_VA = 524 * MiB,
                 WS_QB = 604 * MiB, WS_KB = 684 * MiB, WS_VB = 704 * MiB, WS_OA = 724 * MiB, WS_END = 964 * MiB;
constexpr size_t WO_AIN = 0, WO_AOUT = WO_AIN + 2ull * 3328 * 1024, WO_PIN = WO_AOUT + 2ull * 1024 * 1024, WO_GRP = WO_PIN + 2ull * 2048 * 1024, WO_POUT = WO_GRP + 2ull * 4 * 256 * 256, WO_END = WO_POUT + 2ull * 1024 * 1024;
static_assert(WO_END * 2 <= 32 * MiB, "weights region");
constexpr float C2F = 0.125f * 1.4426950408889634f;
struct EpiP { int li; };
struct EpiQ { unsigned char* ws; const float *qnorm, *knorm, *pscale; };
#define EPB(off) ((bf16_t*)(P.ws + (off)))
#define EPF(off) ((const float*)(P.ws + (off)))
__device__ __forceinline__ float silu_f(float x) { return x * __builtin_amdgcn_rcpf(1.f + __expf(-x)); }
__device__ __forceinline__ void st8(bf16_t* p, const float (&v)[8]) { u32x4 w; w.x = cvt_pk_bf16(v[0], v[1]); w.y = cvt_pk_bf16(v[2], v[3]); w.z = cvt_pk_bf16(v[4], v[5]); w.w = cvt_pk_bf16(v[6], v[7]); *(u32x4*)p = w; }
template <int MODE> struct Epi {
    static constexpr bool PERM = true, AFTER_DRAIN = false;
    EpiP P;
    __device__ __forceinline__ void operator()(const f32x4 (&acc)[2][2][4][2], const Unit& u, int wr, int wc, int fr_, int fq_) const {
        int fr = fr_, fq = fq_; asm volatile("" : "+v"(fr), "+v"(fq)); ArgsP ap_ = argp(); const int li_ = this->P.li; EpiQ P{GPTR(unsigned char, ap_->ws), GPTR(const float, ap_->in[9]) + li_ * 64, GPTR(const float, ap_->in[10]) + li_ * 64, GPTR(const float, ap_->in[14]) + li_ * 1024};
        const int pn = u.pn;
#pragma unroll
        for (int ai = 0; ai < 2; ++ai)
#pragma unroll
          for (int mp = 0; mp < 2; ++mp) {
            f32x4 tabA[2][4];
            if (MODE == 0 && pn < 4) {
#pragma unroll
                for (int mi = 0; mi < 2; ++mi) { const float* tab = EPF(WS_TAB) + ((u.pm * BM + ai * HALF + wr * 64 + (2 * mp + mi) * 16 + fr) & 4095) * 16;
#pragma unroll
                    for (int q = 0; q < 4; ++q) tabA[mi][q] = *(const f32x4*)(tab + 4 * q); } }
#pragma unroll
            for (int mi = 0; mi < 2; ++mi) { const int m = 2 * mp + mi;
                const int row = u.pm * BM + ai * HALF + wr * 64 + m * 16 + fr;
                float v[2][8];
#pragma unroll
                for (int bj = 0; bj < 2; ++bj)
#pragma unroll
                    for (int n = 0; n < 2; ++n)
#pragma unroll
                        for (int e = 0; e < 4; ++e) v[bj][4 * n + e] = acc[ai][bj][m][n][e];
                bf16_t* dst;
                if constexpr (MODE == 0) {
                    const int pos = row & 4095;
                    if (pn < 4) {
                        const f32x4 c0 = tabA[mi][0], c1 = tabA[mi][1], s0 = tabA[mi][2], s1 = tabA[mi][3];
#pragma unroll
                        for (int j = 0; j < 8; ++j) { const float cs = j < 4 ? c0[j & 3] : c1[j & 3], sn = j < 4 ? s0[j & 3] : s1[j & 3];
                            const float other = __shfl_xor(v[0][j], 16); const float r = v[0][j] * cs + other * (fq == 0 ? -sn : sn); if (fq < 2) v[0][j] = r; }
                        if (pn < 2) {
#pragma unroll
                            for (int j = 0; j < 8; ++j) { v[0][j] *= C2F; v[1][j] *= C2F; } }
                        dst = EPB(pn < 2 ? WS_QA : WS_KA) + (size_t)row * 512 + 256 * (pn & 1) + 64 * wc + 8 * fq;
                    } else if (pn < 6) {
                        dst = EPB(WS_VA) + (size_t)row * 512 + 256 * (pn - 4) + 64 * wc + 8 * fq;
                    } else if (pn < 9) {
                        const bool isv = (pn == 8 && wc >= 2);
                        if (!isv) {
                            const float* g = (pn == 8) ? P.knorm : P.qnorm;
                            float ss = 0.f;
#pragma unroll
                            for (int j = 0; j < 8; ++j) ss += v[0][j] * v[0][j] + v[1][j] * v[1][j];
                            ss += __shfl_xor(ss, 16); ss += __shfl_xor(ss, 32);
                            const float rinv = rsqrtf(ss * (1.f / 64.f) + 1e-6f);
#pragma unroll
                            for (int bj = 0; bj < 2; ++bj) { const f32x4 g0 = *(const f32x4*)(g + 32 * bj + 8 * fq), g1 = *(const f32x4*)(g + 32 * bj + 8 * fq + 4);
#pragma unroll
                                for (int j = 0; j < 8; ++j) v[bj][j] *= rinv * (j < 4 ? g0[j & 3] : g1[j & 3]); }
#pragma unroll
                            for (int bj = 0; bj < 2; ++bj) { const int px = bj == 0 ? (pos >> 6) : (pos & 63); const float* tab = EPF(WS_TAB + 4096 * 16 * 4) + px * 32 + 8 * (fq & 1);
                                const f32x4 c0 = *(const f32x4*)(tab), c1 = *(const f32x4*)(tab + 4), s0 = *(const f32x4*)(tab + 16), s1 = *(const f32x4*)(tab + 20);
#pragma unroll
                                for (int j = 0; j < 8; ++j) { const float cs = j < 4 ? c0[j & 3] : c1[j & 3], sn = j < 4 ? s0[j & 3] : s1[j & 3];
                                    const float other = __shfl_xor(v[bj][j], 32); v[bj][j] = v[bj][j] * cs + other * (fq < 2 ? -sn : sn); } }
                            if (pn < 8) {
#pragma unroll
                                for (int j = 0; j < 8; ++j) { v[0][j] *= C2F; v[1][j] *= C2F; } }
                        }
                        if (pn < 8) dst = EPB(WS_QB) + (size_t)row * 512 + 256 * (pn - 6) + 64 * wc + 8 * fq;
                        else if (wc < 2) dst = EPB(WS_KB) + (((size_t)(row >> 12) * 2 + wc) * 4096 + (pos & ~63)) * 64 + fq * 512 + (pos & 63) * 8;
                        else dst = EPB(WS_VB) + (((size_t)(row >> 12) * 2 + (wc - 2)) * 4096 + (pos & ~63)) * 64 + (pos & 63) * 32 + 8 * fq;
                    } else {
#pragma unroll
                        for (int j = 0; j < 8; ++j) { v[0][j] = silu_f(v[0][j]); v[1][j] = silu_f(v[1][j]); }
                        dst = EPB(WS_SG) + (size_t)row * 1024 + 256 * (pn - 9) + 64 * wc + 8 * fq;
                    }
                    st8(dst, v[0]); st8(dst + ((pn == 8) ? 2048 : 32), v[1]);
                } else {
                    const int col = 32 * wc + 8 * fq;
                    if constexpr (MODE == 1) {
                        if (pn < 4) dst = EPB(WS_QA) + (size_t)row * 1024 + 256 * pn + col;
                        else { dst = EPB(WS_SG) + (size_t)row * 1024 + 256 * (pn - 4) + col;
#pragma unroll
                            for (int j = 0; j < 8; ++j) { v[0][j] = silu_f(v[0][j]); v[1][j] = silu_f(v[1][j]); } }
                    } else if constexpr (MODE == 2) {
                        dst = EPB(WS_H) + (size_t)row * 1024 + 256 * pn + col;
#pragma unroll
                        for (int bj = 0; bj < 2; ++bj) { const int cc = 256 * pn + col + 128 * bj; const f32x4 p0 = *(const f32x4*)(P.pscale + cc), p1 = *(const f32x4*)(P.pscale + cc + 4);
                            const u32x4 gv = *(const u32x4*)(EPB(WS_SG) + (size_t)row * 1024 + cc);
#pragma unroll
                            for (int j = 0; j < 8; ++j) { const unsigned w = gv[j >> 1]; const float gf = __uint_as_float((j & 1) ? (w & 0xffff0000u) : (w << 16)); v[bj][j] *= (j < 4 ? p0[j & 3] : p1[j & 3]) * gf; } }
                    } else {
                        dst = EPB(WS_QA) + (size_t)row * 1024 + 256 * pn + col;
                    }
                    st8(dst, v[0]); st8(dst + 128, v[1]);
                }
            }
          }
    }
};
template <class Epi, class Sched, bool ALIGN_EPI = false, bool SP2 = false>
__device__ __forceinline__ void gemm_phase(PG8_LAS unsigned char* lds, const Gemm g, const Sched& S, const Epi& E) {
    int tid_ = threadIdx.x; asm volatile("" : "+v"(tid_));
    const int tid = tid_, wid = __builtin_amdgcn_readfirstlane(tid >> 6), lane = tid & 63, wr = wid >> 2, wc = wid & 3, fr = lane & 15, fq = lane >> 4;
    const char* gA_ = uni_ptr((const char*)g.A); const char* gB_ = uni_ptr((const char*)g.Bt);
    const int K = g.K, nt = K / BK;
    unsigned voffA[2], voffB[2];
#pragma unroll
    for (int i = 0; i < 2; ++i) { int R, C; stage_rc(tid * 16 + i * 8192, R, C); const int Rb = Epi::PERM ? ((R & ~31) + perm32(R & 31)) : R;
        voffA[i] = (unsigned)(R * g.lda + C) * 2u; voffB[i] = (unsigned)(Rb * K + C) * 2u; }
    const size_t kstep = (size_t)(BK * 2);
    const size_t hsA = (size_t)HALF * g.lda * 2, hsB = (size_t)HALF * K * 2;
    const size_t tsA = 2 * hsA, tsB = 2 * hsB;
    const unsigned ldsw = (unsigned)wid * 1024u;
    const int aoff = lds_byte(wr * 64 + fr, fq * 8), boff = lds_byte(wc * 32 + fr, fq * 8);
#define PG8_SA(b, h) (((b) * 2 + (h)) * HTB)
#define PG8_SB(b, h) ((4 + (b) * 2 + (h)) * HTB)
#define PG8_STAGE(bufoff, gbase, voff) do { _Pragma("unroll") for (int _i = 0; _i < 2; ++_i) \
        __builtin_amdgcn_global_load_lds((const unsigned*)((const char*)(gbase) + (voff)[_i]), (PG8_LAS unsigned*)(lds + (bufoff) + ldsw + _i * 8192), 16, 0, 0); } while (0)
#define PG8_LDA(dst, b, h) do { _Pragma("unroll") for (int m = 0; m < 4; ++m) _Pragma("unroll") for (int k = 0; k < 2; ++k) dst[m][k] = *(const PG8_LAS bf16x8*)(lds + PG8_SA(b, h) + aoff + m * 2048 + k * 1024); } while (0)
#define PG8_LDB(dst, b, h) do { _Pragma("unroll") for (int n = 0; n < 2; ++n) _Pragma("unroll") for (int k = 0; k < 2; ++k) dst[n][k] = *(const PG8_LAS bf16x8*)(lds + PG8_SB(b, h) + boff + n * 2048 + k * 1024); } while (0)
#define PG8_MMA(ai, bj, At, Bt) do { __builtin_amdgcn_s_setprio(1); _Pragma("unroll") for (int m = 0; m < 4; ++m) _Pragma("unroll") for (int n = 0; n < 2; ++n) _Pragma("unroll") for (int k = 0; k < 2; ++k) \
        acc[ai][bj][m][n] = __builtin_amdgcn_mfma_f32_16x16x32_bf16(Bt[n][k], At[m][k], acc[ai][bj][m][n], 0, 0, 0); __builtin_amdgcn_s_setprio(0); } while (0)
#define PG8_WAIT_V(n) asm volatile("s_waitcnt vmcnt(" #n ")" ::: "memory")
#define PG8_WAIT_L(n) asm volatile("s_waitcnt lgkmcnt(" #n ")" ::: "memory")
#define PG8_BAR __builtin_amdgcn_s_barrier()
#define PG8_SCHED __builtin_amdgcn_sched_barrier(0)
    Unit cur, nxt; int ui = 0;
    if (!S.next(0, cur)) return;
    f32x4 acc[2][2][4][2];
#pragma unroll
    for (int a = 0; a < 2; ++a)
#pragma unroll
        for (int b = 0; b < 2; ++b)
#pragma unroll
            for (int m = 0; m < 4; ++m)
#pragma unroll
                for (int n = 0; n < 2; ++n) acc[a][b][m][n] = (f32x4){0.f, 0.f, 0.f, 0.f};
    bf16x8 At[4][2], B0[2][2], B1[2][2];
    const char* cA = gA_ + (size_t)cur.pm * tsA + (size_t)cur.pn * g.a_pn_bytes; const char* cB = gB_ + (size_t)cur.pn * tsB;
    S.a_ready(cur);
    if constexpr (SP2) {
        PG8_STAGE(PG8_SB(0, 0), cB, voffB); PG8_STAGE(PG8_SB(0, 1), cB + hsB, voffB); PG8_STAGE(PG8_SA(0, 0), cA, voffA); PG8_STAGE(PG8_SA(0, 1), cA + hsA, voffA);
        if (wr == 1) PG8_BAR;
        PG8_WAIT_V(2); PG8_BAR;
        PG8_STAGE(PG8_SB(1, 0), cB + kstep, voffB); PG8_STAGE(PG8_SA(1, 0), cA + kstep, voffA); PG8_STAGE(PG8_SB(1, 1), cB + hsB + kstep, voffB);
        PG8_WAIT_V(6); PG8_BAR;
    } else {
        PG8_STAGE(PG8_SB(0, 0), cB, voffB); PG8_STAGE(PG8_SA(0, 0), cA, voffA); PG8_STAGE(PG8_SB(0, 1), cB + hsB, voffB); PG8_STAGE(PG8_SA(0, 1), cA + hsA, voffA);
        if (wr == 1) PG8_BAR;
        PG8_WAIT_V(4); PG8_BAR;
        PG8_STAGE(PG8_SB(1, 0), cB + kstep, voffB); PG8_STAGE(PG8_SA(1, 0), cA + kstep, voffA); PG8_STAGE(PG8_SB(1, 1), cB + hsB + kstep, voffB);
        PG8_WAIT_V(6); PG8_BAR;
    }
    for (;;) {
        const bool has_next = S.next(ui + 1, nxt);
        const char* nA = has_next ? gA_ + (size_t)nxt.pm * tsA + (size_t)nxt.pn * g.a_pn_bytes : cA; const char* nB = has_next ? gB_ + (size_t)nxt.pn * tsB : cB;
        for (int t = 0; t < nt; t += 2) {
            const bool last = (t == nt - 2);
            const char* a1 = cA + (size_t)(t + 1) * kstep;
            const char* a2 = last ? nA : cA + (size_t)(t + 2) * kstep; const char* b2 = last ? nB : cB + (size_t)(t + 2) * kstep;
            const char* a3 = a2 + kstep; const char* b3 = b2 + kstep;
            if (last && has_next) S.a_ready(nxt);
            if constexpr (SP2) {
            PG8_LDB(B0, 0, 0); PG8_LDB(B1, 0, 1); PG8_SCHED; PG8_LDA(At, 0, 0); PG8_STAGE(PG8_SA(1, 1), a1 + hsA, voffA);
            PG8_WAIT_V(8); PG8_WAIT_L(0); PG8_BAR; PG8_MMA(0, 0, At, B0); PG8_MMA(0, 1, At, B1); PG8_BAR; PG8_SCHED;
            PG8_LDA(At, 0, 1); PG8_STAGE(PG8_SB(0, 0), b2, voffB); PG8_STAGE(PG8_SB(0, 1), b2 + hsB, voffB); PG8_STAGE(PG8_SA(0, 0), a2, voffA);
            PG8_WAIT_V(8); PG8_WAIT_L(0); PG8_BAR; PG8_MMA(1, 0, At, B0); PG8_MMA(1, 1, At, B1); PG8_BAR; PG8_SCHED;
            PG8_LDB(B0, 1, 0); PG8_LDB(B1, 1, 1); PG8_SCHED; PG8_LDA(At, 1, 0); PG8_STAGE(PG8_SA(0, 1), a2 + hsA, voffA);
            PG8_WAIT_V(8); PG8_WAIT_L(0); PG8_BAR; PG8_MMA(0, 0, At, B0); PG8_MMA(0, 1, At, B1); PG8_BAR; PG8_SCHED;
            PG8_LDA(At, 1, 1); PG8_STAGE(PG8_SB(1, 0), b3, voffB); PG8_STAGE(PG8_SB(1, 1), b3 + hsB, voffB); PG8_STAGE(PG8_SA(1, 0), a3, voffA);
            PG8_WAIT_V(8); PG8_WAIT_L(0); PG8_BAR; PG8_MMA(1, 0, At, B0); PG8_MMA(1, 1, At, B1); PG8_BAR; PG8_SCHED;
            } else {
            PG8_LDB(B0, 0, 0); PG8_SCHED; PG8_LDA(At, 0, 0); PG8_STAGE(PG8_SA(1, 1), a1 + hsA, voffA);
            PG8_WAIT_L(8); PG8_BAR; PG8_WAIT_L(0); PG8_MMA(0, 0, At, B0); PG8_BAR; PG8_SCHED;
            PG8_LDB(B1, 0, 1); PG8_STAGE(PG8_SB(0, 0), b2, voffB);
            PG8_BAR; PG8_WAIT_L(0); PG8_MMA(0, 1, At, B1); PG8_BAR;
            PG8_LDA(At, 0, 1); PG8_STAGE(PG8_SA(0, 0), a2, voffA);
            PG8_BAR; PG8_WAIT_L(0); PG8_MMA(1, 0, At, B0); PG8_BAR; PG8_SCHED;
            PG8_STAGE(PG8_SB(0, 1), b2 + hsB, voffB);
            PG8_WAIT_V(6); PG8_BAR; PG8_MMA(1, 1, At, B1); PG8_BAR;
            PG8_LDB(B0, 1, 0); PG8_SCHED; PG8_LDA(At, 1, 0); PG8_STAGE(PG8_SA(0, 1), a2 + hsA, voffA);
            PG8_WAIT_L(8); PG8_BAR; PG8_WAIT_L(0); PG8_MMA(0, 0, At, B0); PG8_BAR; PG8_SCHED;
            PG8_LDB(B1, 1, 1); PG8_STAGE(PG8_SB(1, 0), b3, voffB);
            PG8_BAR; PG8_WAIT_L(0); PG8_MMA(0, 1, At, B1); PG8_BAR;
            PG8_LDA(At, 1, 1); PG8_STAGE(PG8_SA(1, 0), a3, voffA);
            PG8_BAR; PG8_WAIT_L(0); PG8_MMA(1, 0, At, B0); PG8_BAR; PG8_SCHED;
            PG8_STAGE(PG8_SB(1, 1), b3 + hsB, voffB);
            PG8_WAIT_V(6); PG8_BAR; PG8_MMA(1, 1, At, B1); PG8_BAR;
            }
        }
        if constexpr (ALIGN_EPI) { if (wr == 0) PG8_BAR; }
        if constexpr (!Epi::AFTER_DRAIN) { E(acc, cur, wr, wc, fr, fq); S.done(cur); }
        if (!has_next) break;
#pragma unroll
        for (int a = 0; a < 2; ++a)
#pragma unroll
            for (int b = 0; b < 2; ++b)
#pragma unroll
                for (int m = 0; m < 4; ++m)
#pragma unroll
                    for (int n = 0; n < 2; ++n) acc[a][b][m][n] = (f32x4){0.f, 0.f, 0.f, 0.f};
        cur = nxt; cA = nA; cB = nB; ++ui;
        if constexpr (ALIGN_EPI) { if (wr == 1) PG8_BAR; }
    }
    PG8_WAIT_V(0);
    if constexpr (!ALIGN_EPI) { if (wr == 0) PG8_BAR; }
    PG8_BAR;
    if constexpr (Epi::AFTER_DRAIN) { E.fused(acc, cur, wr, wc, fr, fq, lds, wid, lane); S.done(cur); }
#undef PG8_SA
#undef PG8_SB
#undef PG8_STAGE
#undef PG8_LDA
#undef PG8_LDB
#undef PG8_MMA
#undef PG8_WAIT_V
#undef PG8_WAIT_L
#undef PG8_BAR
#undef PG8_SCHED
}
}
#include <hip/hip_bf16.h>
#include <cmath>
namespace attn_body {
using bf16=__hip_bfloat16;
using bf16x8=__attribute__((ext_vector_type(8)))short;
using s16x4=__attribute__((ext_vector_type(4)))short;
using f32x16=__attribute__((ext_vector_type(16)))float;
using u32x4=__attribute__((ext_vector_type(4)))unsigned;
constexpr int SEQ=4096,D=64,QP=512,KP=128,VP=128,OP=1024;
constexpr int NW=8,QBLK=32,QB=QBLK*NW,KVBLK=64,NQB=SEQ/QB;
constexpr int ATTN_UNIT_ROWS=QB;
__device__ __forceinline__ int crow(int r,int hi){return (r&3)+8*(r>>2)+4*hi;}
#define SBAR() __builtin_amdgcn_sched_barrier(0)
__device__ __forceinline__ void cmask(f32x16&p0,f32x16&p1,int jb,int qrel,int hi){
  const float NEG=-INFINITY; int kb=64*jb+4*hi;
  #pragma unroll
  for(int r=0;r<16;++r){int kv=kb+(r&3)+8*(r>>2); if(kv>qrel)p0[r]=NEG; if(kv+32>qrel)p1[r]=NEG;}
}

constexpr int NSLOT=3, SLOTB=8192;
constexpr int LDS_K=0, LDS_V=NSLOT*SLOTB, LDS_WS=2*NSLOT*SLOTB, LDS_OST=LDS_WS+NW*64*4, LDS_BYTES=LDS_OST+NW*4096;
constexpr float C2=0.125f*1.4426950408889634f;
__device__ __forceinline__ void glds16(const void*gsrc,unsigned lds_dst){unsigned keep;
  asm volatile("s_mov_b32 %0, m0\n\ts_mov_b32 m0, %2\n\ts_nop 0\n\tglobal_load_lds_dwordx4 %1, off\n\ts_mov_b32 m0, %0":"=&s"(keep):"v"(gsrc),"s"(lds_dst):"memory");}
__device__ __forceinline__ float max3f(float a,float b,float c){float r;asm("v_max3_f32 %0, %1, %2, %3":"=v"(r):"v"(a),"v"(b),"v"(c));return r;}
__device__ __forceinline__ float max2f(float a,float b){float r;asm("v_max_f32_e32 %0, %1, %2":"=v"(r):"v"(a),"v"(b));return r;}
__device__ __forceinline__ float fadd_s(float a,float b){float r;asm("v_add_f32_e32 %0, %1, %2":"=v"(r):"v"(a),"v"(b));return r;}
__device__ __forceinline__ float fsub_s(float a,float b){float r;asm("v_sub_f32_e32 %0, %1, %2":"=v"(r):"v"(a),"v"(b));return r;}
typedef float f32x2_t __attribute__((ext_vector_type(2))); typedef __bf16 bf16x2_t __attribute__((ext_vector_type(2)));
__device__ __forceinline__ unsigned cvtpk_s(float lo,float hi){f32x2_t v={lo,hi};bf16x2_t b=__builtin_convertvector(v,bf16x2_t);return __builtin_bit_cast(unsigned,b);}
#define WAIT_BAR(N) asm volatile("s_waitcnt vmcnt(" #N ") lgkmcnt(0)\n\ts_barrier":::"memory")

__device__ __forceinline__ void qkt(f32x16&p0,f32x16&p1,const char*Kslot,const bf16x8*qr,const f32x16&negm,int r32,int hi){
  const char*kb=Kslot+hi*1024+r32*16;
  #pragma unroll
  for(int d0=0;d0<4;++d0){
    const bf16x8 b0=*reinterpret_cast<const bf16x8*>(kb+d0*2048);
    const bf16x8 b1=*reinterpret_cast<const bf16x8*>(kb+d0*2048+512);
    if(d0==0){p0=__builtin_amdgcn_mfma_f32_32x32x16_bf16(b0,qr[0],negm,0,0,0);p1=__builtin_amdgcn_mfma_f32_32x32x16_bf16(b1,qr[0],negm,0,0,0);}
    else{p0=__builtin_amdgcn_mfma_f32_32x32x16_bf16(b0,qr[d0],p0,0,0,0);p1=__builtin_amdgcn_mfma_f32_32x32x16_bf16(b1,qr[d0],p1,0,0,0);}}
}
typedef __attribute__((address_space(3))) const char* lds_cptr;
typedef short v4i16_t __attribute__((ext_vector_type(4)));
__device__ __forceinline__ void kload8(bf16x8*kf,lds_cptr kp){
  kf[0]=*(const __attribute__((address_space(3))) bf16x8*)(kp);      kf[1]=*(const __attribute__((address_space(3))) bf16x8*)(kp+512);
  kf[2]=*(const __attribute__((address_space(3))) bf16x8*)(kp+2048); kf[3]=*(const __attribute__((address_space(3))) bf16x8*)(kp+2560);
  kf[4]=*(const __attribute__((address_space(3))) bf16x8*)(kp+4096); kf[5]=*(const __attribute__((address_space(3))) bf16x8*)(kp+4608);
  kf[6]=*(const __attribute__((address_space(3))) bf16x8*)(kp+6144); kf[7]=*(const __attribute__((address_space(3))) bf16x8*)(kp+6656);
}
__device__ __forceinline__ void kload2(bf16x8*kf,lds_cptr kp,int j){ kf[2*j]=*(const __attribute__((address_space(3))) bf16x8*)(kp+j*2048); kf[2*j+1]=*(const __attribute__((address_space(3))) bf16x8*)(kp+j*2048+512); }
__device__ __forceinline__ s16x4 vtr(lds_cptr p){ return __builtin_bit_cast(s16x4,__builtin_amdgcn_ds_read_tr16_b64_v4i16((__attribute__((address_space(3))) v4i16_t*)p)); }
__device__ __forceinline__ float rowmax(const f32x16&p0,const f32x16&p1){
  float a=max3f(p0[0],p0[1],p1[0]),b=max3f(p0[2],p0[3],p1[1]);a=max3f(a,p1[2],p1[3]);
  #pragma unroll
  for(int r=4;r<16;r+=4){a=max3f(a,p0[r],p0[r+1]);b=max3f(b,p0[r+2],p0[r+3]);a=max3f(a,p1[r],p1[r+1]);b=max3f(b,p1[r+2],p1[r+3]);}
  const float m=max2f(a,b);
  auto rr=__builtin_amdgcn_permlane32_swap(__float_as_uint(m),__float_as_uint(m),false,false);
  return max2f(__uint_as_float(rr[0]),__uint_as_float(rr[1]));
}
__device__ __forceinline__ void pv(f32x16*o,int vb,bf16x8 pa0,bf16x8 pa1,bf16x8 pa2,bf16x8 pa3){
  #pragma unroll
  for(int d0=0;d0<2;++d0){s16x4 lo[4],hi[4];
    #pragma unroll
    for(int ks=0;ks<4;++ks){
      asm volatile("ds_read_b64_tr_b16 %0,%1 offset:%c2":"=&v"(lo[ks]):"v"(vb),"i"(d0*4096+ks*1024):"memory");
      asm volatile("ds_read_b64_tr_b16 %0,%1 offset:%c2":"=&v"(hi[ks]):"v"(vb),"i"(d0*4096+ks*1024+512):"memory");}
    asm volatile("s_waitcnt lgkmcnt(0)":::"memory");SBAR();
    #define PK(k) (bf16x8){lo[k][0],lo[k][1],lo[k][2],lo[k][3],hi[k][0],hi[k][1],hi[k][2],hi[k][3]}
    o[d0]=__builtin_amdgcn_mfma_f32_32x32x16_bf16(pa0,PK(0),o[d0],0,0,0);
    o[d0]=__builtin_amdgcn_mfma_f32_32x32x16_bf16(pa1,PK(1),o[d0],0,0,0);
    o[d0]=__builtin_amdgcn_mfma_f32_32x32x16_bf16(pa2,PK(2),o[d0],0,0,0);
    o[d0]=__builtin_amdgcn_mfma_f32_32x32x16_bf16(pa3,PK(3),o[d0],0,0,0);
    #undef PK
  }
}

__device__ __forceinline__ u32x4 mulgate(u32x4 v,u32x4 g){ u32x4 r;
  #pragma unroll
  for(int i=0;i<4;++i){ const float a0=__uint_as_float(v[i]<<16),a1=__uint_as_float(v[i]&0xffff0000u),g0=__uint_as_float(g[i]<<16),g1=__uint_as_float(g[i]&0xffff0000u); r[i]=cvtpk_s(a0*g0,a1*g1);} return r; }
#ifndef ATTN_STORE16
#define ATTN_STORE16(p,v) (*(u32x4*)(p)=(v))
#endif
template<int THRL> __device__ __forceinline__ void attn_unit(int b,int h,int qb,const bf16*Q,const bf16*__restrict__ K,const bf16*__restrict__ V,bf16*O,const bf16*SG,char*shm,bool pre,bf16x8*qio,bool has_next,int nb,int nh,int nqb){
  int tid_=threadIdx.x; asm volatile("":"+v"(tid_)); const int tid=tid_,lane=tid&63,r32=lane&31,hi=lane>>5; const int wid=__builtin_amdgcn_readfirstlane(tid>>6);
  const long rowbase=(long)b*SEQ; const int q0=qb*QB;
  const bf16*Qw=Q+(rowbase+q0+wid*QBLK)*QP+h*D;
  const bf16*Kh=K+((long)b*2+(h>>2))*SEQ*D,*Vh=V+((long)b*2+(h>>2))*SEQ*D;
  const unsigned lds0=(unsigned)(uintptr_t)shm;
  float*wsf=(float*)(shm+LDS_WS)+wid*64;
  const bf16*ksrc=Kh+wid*512+lane*8;
  const bf16*vsrc=Vh+(wid>>2)*2048+(16*(wid&3)+(lane>>2))*32+(lane&3)*8;
  const unsigned kdst=lds0+LDS_K+wid*1024, vdst=lds0+LDS_V+wid*1024;
  #define DMA_K(t,slot) glds16(ksrc+(long)(t)*KVBLK*D,(unsigned)__builtin_amdgcn_readfirstlane(kdst+(slot)))
  #define DMA_V(t,slot) glds16(vsrc+(long)(t)*KVBLK*D,(unsigned)__builtin_amdgcn_readfirstlane(vdst+(slot)))
  const int vb0=(int)(lds0+LDS_V)+((lane>>4)&1)*32+(lane&3)*8+(4*hi+((lane&15)>>2))*64;
  const char*Kbase=shm+LDS_K; bf16x8 kf[8];
  const lds_cptr shm3=(lds_cptr)shm; const lds_cptr kp0=shm3+LDS_K+hi*1024+r32*16; const lds_cptr vp0=shm3+LDS_V+((lane>>4)&1)*32+(lane&3)*8+(4*hi+((lane&15)>>2))*64;
  const int NT=SEQ/KVBLK;
  if(!pre){DMA_K(0,0);DMA_V(0,0);DMA_K(1,SLOTB);}
  bf16x8 qr[4];
  #pragma unroll
  for(int d0=0;d0<4;++d0)qr[d0]=*reinterpret_cast<const bf16x8*>(&Qw[(long)r32*QP+d0*16+hi*8]);
  float mhat=0.f,l_reg=0.f;f32x16 o[2];o[0]=f32x16{};o[1]=f32x16{};f32x16 negm=f32x16{};asm volatile("":"+v"(negm));

  #define CMASK(P0,P1,t) do{}while(0)
  bool resc=false;
  #define START(P0,P1) do{ const float rm=rowmax(P0,P1); resc=false; \
    { const float dl=rm; mhat=fadd_s(mhat,dl); \
      _Pragma("unroll") for(int r=0;r<16;++r){P0[r]=fsub_s(P0[r],dl);P1[r]=fsub_s(P1[r],dl);} \
      _Pragma("unroll") for(int r=0;r<16;++r)negm[r]=-mhat; asm volatile("":"+v"(negm)); } \
    _Pragma("unroll") for(int r=0;r<16;++r)P0[r]=__builtin_amdgcn_exp2f(P0[r]); }while(0)
  #define RESC() do{ if(resc){ asm volatile("s_waitcnt lgkmcnt(0)":::"memory"); \
      _Pragma("unroll") for(int d_=0;d_<2;++d_) _Pragma("unroll") for(int r=0;r<16;++r)o[d_][r]*=wsf[crow(r,hi)]; } }while(0)
  f32x16 pA0,pA1,pB0,pB1;
  int sl_prev=0,sl_cur=0,sl_next=SLOTB;
  #define ROT() do{sl_prev=sl_cur;sl_cur=sl_next;sl_next=(sl_next==(NSLOT-1)*SLOTB)?0:sl_next+SLOTB;}while(0)
  if(!pre)DMA_K(2,2*SLOTB);
  WAIT_BAR(3);
  qkt(pA0,pA1,Kbase,qr,negm,r32,hi);asm volatile("s_nop 15\n\ts_nop 7":"+v"(pA0),"+v"(pA1));CMASK(pA0,pA1,0);
  START(pA0,pA1);
  _Pragma("unroll") for(int r=0;r<16;++r)pA1[r]=__builtin_amdgcn_exp2f(pA1[r]);
  WAIT_BAR(0);
  DMA_K(3,0);DMA_V(1,SLOTB);
  ROT();
  kload8(kf,kp0+sl_cur);
  WAIT_BAR(2);
  s16x4 vlo[8],vhi[8]; u32x4 pw0,pw1,pw2,pw3;
  #define PKW(P,B) cvtpk_s(P[B],P[B+1])
  #define PAF(k) __builtin_bit_cast(bf16x8,pw##k)
  #define VFR(i) (bf16x8){vlo[i][0],vlo[i][1],vlo[i][2],vlo[i][3],vhi[i][0],vhi[i][1],vhi[i][2],vhi[i][3]}
  #define PIN(x) asm volatile("":"+v"(x))
  #define MX3(a,b,c) __builtin_fmaxf(__builtin_fmaxf((a),(b)),(c))
  #define GAPA(MF,A0,A1,A2,A3,W0,W1,PW) do{ MF; sacc+=A0; sacc+=A1; sacc+=A2; sacc+=A3; PIN(sacc); W0; W1; PIN(PW); SBAR(); }while(0)
  #define EX(v) __builtin_amdgcn_exp2f(v)
  #define GAPB(MF,X,B) do{ MF; X[B]=EX(X[B]); X[B+1]=EX(X[B+1]); X[B+2]=EX(X[B+2]); X[B+3]=EX(X[B+3]); PIN(X); SBAR(); }while(0)
  #define VRD(i) do{ vlo[i]=vtr(vp_+(((i)>>2)*4096+((i)&3)*1024)); vhi[i]=vtr(vp_+(((i)>>2)*4096+((i)&3)*1024+512)); }while(0)
  #define KRD(G,j) do{ if(G){ kload2(kf,kp0+sl_next,j); SBAR(); } }while(0)
  #define STEP(C0,C1,P0,P1,t,GK,GV,GL) do{ SBAR(); \
    const lds_cptr vp_=vp0+sl_prev; \
    VRD(0); SBAR(); float sacc=(P0[0]+P0[1]); \
    GAPA(C0=__builtin_amdgcn_mfma_f32_32x32x16_bf16(kf[0],qr[0],negm,0,0,0), P0[2],P0[3],P0[4],P0[5],     pw0[0]=PKW(P0,0), pw0[1]=PKW(P0,2), pw0); \
    VRD(4); SBAR(); GAPA(C1=__builtin_amdgcn_mfma_f32_32x32x16_bf16(kf[1],qr[0],negm,0,0,0), P0[6],P0[7],P0[8],P0[9],     pw0[2]=PKW(P0,4), pw0[3]=PKW(P0,6), pw0); \
    VRD(1); SBAR(); GAPA(C0=__builtin_amdgcn_mfma_f32_32x32x16_bf16(kf[2],qr[1],C0,0,0,0),   P0[10],P0[11],P0[12],P0[13], pw1[0]=PKW(P0,8), pw1[1]=PKW(P0,10), pw1); \
    VRD(5); SBAR(); GAPA(C1=__builtin_amdgcn_mfma_f32_32x32x16_bf16(kf[3],qr[1],C1,0,0,0),   P0[14],P0[15],P1[0],P1[1],   pw1[2]=PKW(P0,12),pw1[3]=PKW(P0,14), pw1); \
    VRD(2); SBAR(); GAPA(C0=__builtin_amdgcn_mfma_f32_32x32x16_bf16(kf[4],qr[2],C0,0,0,0),   P1[2],P1[3],P1[4],P1[5],     pw2[0]=PKW(P1,0), pw2[1]=PKW(P1,2), pw2); \
    VRD(6); SBAR(); GAPA(C1=__builtin_amdgcn_mfma_f32_32x32x16_bf16(kf[5],qr[2],C1,0,0,0),   P1[6],P1[7],P1[8],P1[9],     pw2[2]=PKW(P1,4), pw2[3]=PKW(P1,6), pw2); \
    VRD(3); SBAR(); GAPA(C0=__builtin_amdgcn_mfma_f32_32x32x16_bf16(kf[6],qr[3],C0,0,0,0),   P1[10],P1[11],P1[12],P1[13], pw3[0]=PKW(P1,8), pw3[1]=PKW(P1,10), pw3); \
    VRD(7); SBAR(); GAPA(C1=__builtin_amdgcn_mfma_f32_32x32x16_bf16(kf[7],qr[3],C1,0,0,0),   P1[14],P1[15],0.f,0.f,       pw3[2]=PKW(P1,12),pw3[3]=PKW(P1,14), pw3); \
    l_reg+=sacc; \
    if(GK){DMA_K((t)+3,sl_cur);} if(GV){DMA_V((t)+1,sl_next);} \
    CMASK(C0,C1,t); \
    { float a=MX3(C0[0],C0[1],C1[0]),b=MX3(C0[2],C0[3],C1[1]); a=MX3(a,C1[2],C1[3]); \
      _Pragma("unroll") for(int r=4;r<16;r+=4){a=MX3(a,C0[r],C0[r+1]);b=MX3(b,C0[r+2],C0[r+3]);a=MX3(a,C1[r],C1[r+1]);b=MX3(b,C1[r+2],C1[r+3]);} \
      float rm=__builtin_fmaxf(a,b); { auto rr=__builtin_amdgcn_permlane32_swap(__float_as_uint(rm),__float_as_uint(rm),false,false); rm=__builtin_fmaxf(__uint_as_float(rr[0]),__uint_as_float(rr[1])); } \
      resc=false; \
      if(__builtin_expect(__any(rm>(float)THRL),0)){ const float dl=__builtin_fmaxf(rm,0.f); mhat+=dl; \
        _Pragma("unroll") for(int r=0;r<16;++r){C0[r]-=dl;C1[r]-=dl;} \
        _Pragma("unroll") for(int r=0;r<16;++r)negm[r]=-mhat; asm volatile("":"+v"(negm)); \
        const float f=__builtin_amdgcn_exp2f(-dl); l_reg*=f; if(hi==0)wsf[r32]=f; resc=true; } } \
    SBAR(); \
    GAPB(o[0]=__builtin_amdgcn_mfma_f32_32x32x16_bf16(PAF(0),VFR(0),o[0],0,0,0), C0,0); \
    GAPB(o[1]=__builtin_amdgcn_mfma_f32_32x32x16_bf16(PAF(0),VFR(4),o[1],0,0,0), C0,4); \
    KRD(GL,0); GAPB(o[0]=__builtin_amdgcn_mfma_f32_32x32x16_bf16(PAF(1),VFR(1),o[0],0,0,0), C0,8); \
    KRD(GL,1); GAPB(o[1]=__builtin_amdgcn_mfma_f32_32x32x16_bf16(PAF(1),VFR(5),o[1],0,0,0), C0,12); \
    KRD(GL,2); GAPB(o[0]=__builtin_amdgcn_mfma_f32_32x32x16_bf16(PAF(2),VFR(2),o[0],0,0,0), C1,0); \
    KRD(GL,3); GAPB(o[1]=__builtin_amdgcn_mfma_f32_32x32x16_bf16(PAF(2),VFR(6),o[1],0,0,0), C1,4); \
    GAPB(o[0]=__builtin_amdgcn_mfma_f32_32x32x16_bf16(PAF(3),VFR(3),o[0],0,0,0), C1,8); \
    GAPB(o[1]=__builtin_amdgcn_mfma_f32_32x32x16_bf16(PAF(3),VFR(7),o[1],0,0,0), C1,12); \
    }while(0)
  int t=1;
  #undef CMASK
  #define CMASK(P0,P1,t) do{}while(0)
  for(;t+5<NT;t+=2){
    STEP(pB0,pB1,pA0,pA1,t,true,true,true);     WAIT_BAR(2); RESC(); ROT();
    STEP(pA0,pA1,pB0,pB1,t+1,true,true,true);   WAIT_BAR(2); RESC(); ROT();
  }
  #undef CMASK
  #define CMASK(P0,P1,t) do{}while(0)
  #define ENDW(tt) do{ if((tt)+3<NT){WAIT_BAR(2);} else if((tt)+2<NT){WAIT_BAR(1);} else {WAIT_BAR(0);} }while(0)
  for(;t+1<NT;t+=2){
    STEP(pB0,pB1,pA0,pA1,t,(t+3<NT),(t+1<NT),(t+1<NT));       ENDW(t);   RESC(); ROT();
    STEP(pA0,pA1,pB0,pB1,t+1,(t+4<NT),(t+2<NT),(t+2<NT));     ENDW(t+1); RESC(); ROT();
  }
  STEP(pB0,pB1,pA0,pA1,NT-1,false,false,false); RESC();
  { float sacc=pB0[0]+pB0[1]; _Pragma("unroll") for(int r=2;r<16;++r)sacc+=pB0[r]; _Pragma("unroll") for(int r=0;r<16;++r)sacc+=pB1[r]; l_reg+=sacc;
    pw0=(u32x4){PKW(pB0,0),PKW(pB0,2),PKW(pB0,4),PKW(pB0,6)};pw1=(u32x4){PKW(pB0,8),PKW(pB0,10),PKW(pB0,12),PKW(pB0,14)};pw2=(u32x4){PKW(pB1,0),PKW(pB1,2),PKW(pB1,4),PKW(pB1,6)};pw3=(u32x4){PKW(pB1,8),PKW(pB1,10),PKW(pB1,12),PKW(pB1,14)};
    SBAR(); pv(o,vb0+sl_cur,PAF(0),PAF(1),PAF(2),PAF(3)); }
  if(has_next){ asm volatile("s_waitcnt lgkmcnt(0)\n\ts_barrier":::"memory");
    const long nrb=(long)nb*SEQ; const bf16*nKh=K+((long)nb*2+(nh>>2))*SEQ*D,*nVh=V+((long)nb*2+(nh>>2))*SEQ*D;
    const bf16*nks=nKh+wid*512+lane*8; const bf16*nvs=nVh+(wid>>2)*2048+(16*(wid&3)+(lane>>2))*32+(lane&3)*8;
    glds16(nks,(unsigned)__builtin_amdgcn_readfirstlane(kdst)); glds16(nvs,(unsigned)__builtin_amdgcn_readfirstlane(vdst)); glds16(nks+(long)KVBLK*D,(unsigned)__builtin_amdgcn_readfirstlane(kdst+SLOTB));
    (void)nrb; (void)nqb; (void)qio;
    glds16(nks+(long)2*KVBLK*D,(unsigned)__builtin_amdgcn_readfirstlane(kdst+2*SLOTB)); }
  #undef PKW
  #undef PAF
  #undef VFR
  #undef PIN
  #undef MX3
  #undef GAPA
  #undef GAPB
  #undef EX
  #undef VRD
  #undef KRD
  #undef STEP
  #undef ENDW
  {auto rr=__builtin_amdgcn_permlane32_swap(__float_as_uint(l_reg),__float_as_uint(l_reg),false,false);l_reg=__uint_as_float(rr[0])+__uint_as_float(rr[1]);}
  if(hi==0)wsf[32+r32]=l_reg;asm volatile("s_waitcnt lgkmcnt(0)":::"memory");
  float rli[16];
  #pragma unroll
  for(int r=0;r<16;++r)rli[r]=__builtin_amdgcn_rcpf(wsf[32+crow(r,hi)]);
  bf16*Ow=O+(rowbase+q0+wid*QBLK)*OP+512+h*D; const bf16*Gw=SG+(rowbase+q0+wid*QBLK)*OP+512+h*D;
  { bf16*stg=(bf16*)(shm+LDS_OST)+wid*2048;
    #pragma unroll
    for(int r=0;r<16;++r){const int orow=crow(r,hi);
      #pragma unroll
      for(int d0=0;d0<2;++d0)stg[orow*64+d0*32+r32]=__float2bfloat16(o[d0][r]*rli[r]);}
    asm volatile("s_waitcnt lgkmcnt(0)":::"memory");
    #pragma unroll
    for(int i=0;i<4;++i){const int row=i*8+(lane>>3),ch=lane&7; u32x4 v=*(const u32x4*)(stg+row*64+ch*8); const u32x4 gv=*(const u32x4*)(Gw+(long)row*OP+ch*8); v=mulgate(v,gv); ATTN_STORE16(Ow+(long)row*OP+ch*8,v);} }
  if(!has_next)asm volatile("s_waitcnt lgkmcnt(0)\n\ts_barrier":::"memory");
  else asm volatile("s_waitcnt lgkmcnt(0)":::"memory");
  #undef DMA_K
  #undef DMA_V
  #undef CMASK
  #undef START
  #undef RESC
  #undef ROT
}
constexpr int ATTN_LDS_BYTES=LDS_BYTES;
#undef SBAR
#undef WAIT_BAR
}
namespace win {
using attn_body::bf16; using attn_body::bf16x8; using attn_body::s16x4; using attn_body::f32x16; using attn_body::u32x4;
typedef __attribute__((address_space(3))) char* lptr;
#define WIN_WAITV0() asm volatile("s_waitcnt vmcnt(0)" ::: "memory")
#define WIN_WAITL0() asm volatile("s_waitcnt lgkmcnt(0)" ::: "memory")
__device__ __forceinline__ int clampi(int v, int lo, int hi) { return v < lo ? lo : (v > hi ? hi : v); }
__device__ __forceinline__ void issue_tile(bf16x8* kf, const bf16* Kc, const bf16* Vc, int k0, int L, int ld, int r32, int hi, int lane, unsigned vdst) {
#pragma unroll
  for (int s = 0; s < 2; ++s) { const int key = clampi(k0 + r32 + 32 * s, 0, L - 1); const bf16* kr = Kc + ((long)key << ld) * 512 + hi * 8;
#pragma unroll
    for (int j = 0; j < 4; ++j) kf[2 * j + s] = *reinterpret_cast<const bf16x8*>(kr + j * 16); }
#pragma unroll
  for (int w = 0; w < 8; ++w) { const int key = clampi(k0 + 16 * (w & 3) + (lane >> 2), 0, L - 1);
    attn_body::glds16(Vc + ((long)key << ld) * 512 + (w >> 2) * 32 + (lane & 3) * 8, (unsigned)__builtin_amdgcn_readfirstlane(vdst + w * 1024)); }
}
__device__ __forceinline__ void tile_step(const bf16x8* kf, const bf16x8* qr, f32x16* o, float& mrun, float& lrun, int k0, int qi, int L, int hi, int r32, int vb, volatile __attribute__((address_space(3))) float* wsf) {
  f32x16 p0 = f32x16{}, p1 = f32x16{};
#pragma unroll
  for (int d0 = 0; d0 < 4; ++d0) { p0 = __builtin_amdgcn_mfma_f32_32x32x16_bf16(kf[2 * d0], qr[d0], p0, 0, 0, 0); p1 = __builtin_amdgcn_mfma_f32_32x32x16_bf16(kf[2 * d0 + 1], qr[d0], p1, 0, 0, 0); }
#pragma unroll
  for (int r = 0; r < 16; ++r) { const int kk = k0 + attn_body::crow(r, hi); const int d0_ = kk - qi, d1_ = d0_ + 32;
    const bool ok0 = (kk >= 0) && (kk < L) && (d0_ <= 64) && (d0_ >= -64); const bool ok1 = (kk + 32 >= 0) && (kk + 32 < L) && (d1_ <= 64) && (d1_ >= -64);
    p0[r] = ok0 ? p0[r] : -1e30f; p1[r] = ok1 ? p1[r] : -1e30f; }
  float rm = p0[0];
#pragma unroll
  for (int r = 1; r < 16; ++r) rm = fmaxf(rm, p0[r]);
#pragma unroll
  for (int r = 0; r < 16; ++r) rm = fmaxf(rm, p1[r]);
  { auto rr = __builtin_amdgcn_permlane32_swap(__float_as_uint(rm), __float_as_uint(rm), false, false); rm = fmaxf(__uint_as_float(rr[0]), __uint_as_float(rr[1])); }
  const float mnew = fmaxf(mrun, rm); const float alpha = __builtin_amdgcn_exp2f(mrun - mnew); mrun = mnew;
  float s = 0.f;
#pragma unroll
  for (int r = 0; r < 16; ++r) { p0[r] = __builtin_amdgcn_exp2f(p0[r] - mnew); p1[r] = __builtin_amdgcn_exp2f(p1[r] - mnew); s += p0[r] + p1[r]; }
  lrun = lrun * alpha + s;
  if (__any(alpha != 1.f)) {
    if (hi == 0) wsf[r32] = alpha;
    WIN_WAITL0();
#pragma unroll
    for (int r = 0; r < 16; ++r) { const float f = wsf[attn_body::crow(r, hi)]; o[0][r] *= f; o[1][r] *= f; }
  }
  u32x4 pw0, pw1, pw2, pw3;
#define WPK(P, B) attn_body::cvtpk_s(P[B], P[B + 1])
  pw0 = (u32x4){WPK(p0, 0), WPK(p0, 2), WPK(p0, 4), WPK(p0, 6)}; pw1 = (u32x4){WPK(p0, 8), WPK(p0, 10), WPK(p0, 12), WPK(p0, 14)};
  pw2 = (u32x4){WPK(p1, 0), WPK(p1, 2), WPK(p1, 4), WPK(p1, 6)}; pw3 = (u32x4){WPK(p1, 8), WPK(p1, 10), WPK(p1, 12), WPK(p1, 14)};
#undef WPK
  __builtin_amdgcn_sched_barrier(0);
  attn_body::pv(o, vb, __builtin_bit_cast(bf16x8, pw0), __builtin_bit_cast(bf16x8, pw1), __builtin_bit_cast(bf16x8, pw2), __builtin_bit_cast(bf16x8, pw3));
}
__device__ __forceinline__ void win_task(int b, int h, int ld, int c, int i0, const bf16* QA, const bf16* KA, const bf16* VA, bf16* OA, float* LSE, lptr wl, volatile __attribute__((address_space(3))) float* wsf, int lane) {
  const int r32 = lane & 31, hi = lane >> 5; const int L = 4096 >> ld; const long rowbase = (long)b * 4096;
  const bf16* Kc = KA + (rowbase + c) * 512 + h * 64; const bf16* Vc = VA + (rowbase + c) * 512 + h * 64;
  const unsigned vdst = (unsigned)(uintptr_t)wl;
  const int vb0 = (int)vdst + ((lane >> 4) & 1) * 32 + (lane & 3) * 8 + (4 * hi + ((lane & 15) >> 2)) * 64;
  bf16x8 kfA[8], kfB[8], kfC[8];
  issue_tile(kfA, Kc, Vc, i0, L, ld, r32, hi, lane, vdst);
  const bf16* Qrow = QA + (rowbase + ((long)(i0 + r32) << ld) + c) * 512 + h * 64 + hi * 8;
  bf16x8 qr[4];
#pragma unroll
  for (int d0 = 0; d0 < 4; ++d0) qr[d0] = *reinterpret_cast<const bf16x8*>(Qrow + d0 * 16);
  f32x16 o[2]; o[0] = f32x16{}; o[1] = f32x16{}; float mrun = -1e30f, lrun = 0.f; const int qi = i0 + r32;
  WIN_WAITV0(); issue_tile(kfB, Kc, Vc, i0 - 64, L, ld, r32, hi, lane, vdst + 8192);
  tile_step(kfA, qr, o, mrun, lrun, i0, qi, L, hi, r32, vb0, wsf);
  WIN_WAITV0(); issue_tile(kfC, Kc, Vc, i0 + 64, L, ld, r32, hi, lane, vdst);
  tile_step(kfB, qr, o, mrun, lrun, i0 - 64, qi, L, hi, r32, vb0 + 8192, wsf);
  WIN_WAITV0();
  tile_step(kfC, qr, o, mrun, lrun, i0 + 64, qi, L, hi, r32, vb0, wsf);
  { auto rr = __builtin_amdgcn_permlane32_swap(__float_as_uint(lrun), __float_as_uint(lrun), false, false); lrun = __uint_as_float(rr[0]) + __uint_as_float(rr[1]); }
  const long tok = rowbase + ((long)qi << ld) + c;
  if (hi == 0) { wsf[32 + r32] = lrun; LSE[tok * 8 + h] = mrun + __builtin_amdgcn_logf(lrun); }
  WIN_WAITL0();
  __attribute__((address_space(3))) unsigned short* stg = (__attribute__((address_space(3))) unsigned short*)(wl + 8192);
#pragma unroll
  for (int r = 0; r < 16; ++r) { const int orow = attn_body::crow(r, hi); const float rl = __builtin_amdgcn_rcpf(wsf[32 + orow]);
#pragma unroll
    for (int d0 = 0; d0 < 2; ++d0) stg[orow * 64 + d0 * 32 + r32] = (unsigned short)(attn_body::cvtpk_s(o[d0][r] * rl, 0.f) & 0xffffu); }
  WIN_WAITL0();
#pragma unroll
  for (int i = 0; i < 4; ++i) { const int row = i * 8 + (lane >> 3), ch = lane & 7; const u32x4 v = *(const __attribute__((address_space(3))) u32x4*)(stg + row * 64 + ch * 8);
    *(u32x4*)(OA + (rowbase + ((long)(i0 + row) << ld) + c) * 512 + h * 64 + ch * 8) = v; }
  WIN_WAITL0();
}
template <int S> __device__ __forceinline__ void tile_step2(const bf16x8* kf, const bf16x8* qr, f32x16* o, f32x16& negm, float& mrun, float& lrun, int k0, int qi, int L, int hi, int r32, int vb, volatile __attribute__((address_space(3))) float* wsf) {
  f32x16 p0, p1;
  if (S == 0) { p0 = __builtin_amdgcn_mfma_f32_32x32x16_bf16(kf[0], qr[0], f32x16{}, 0, 0, 0); p1 = __builtin_amdgcn_mfma_f32_32x32x16_bf16(kf[1], qr[0], f32x16{}, 0, 0, 0); }
  else { p0 = __builtin_amdgcn_mfma_f32_32x32x16_bf16(kf[0], qr[0], negm, 0, 0, 0); p1 = __builtin_amdgcn_mfma_f32_32x32x16_bf16(kf[1], qr[0], negm, 0, 0, 0); }
#pragma unroll
  for (int d0 = 1; d0 < 4; ++d0) { p0 = __builtin_amdgcn_mfma_f32_32x32x16_bf16(kf[2 * d0], qr[d0], p0, 0, 0, 0); p1 = __builtin_amdgcn_mfma_f32_32x32x16_bf16(kf[2 * d0 + 1], qr[d0], p1, 0, 0, 0); }
  if (S != 0) {
    const int dlt = k0 - qi; int lo = (-64 - dlt) > (-k0) ? (-64 - dlt) : (-k0); int up = (64 - dlt) < (L - 1 - k0) ? (64 - dlt) : (L - 1 - k0); lo -= 4 * hi; up -= 4 * hi;
#pragma unroll
    for (int r = 0; r < 16; ++r) { const int c0 = (r & 3) + 8 * (r >> 2), c1 = c0 + 32;
      p0[r] = (c0 >= lo && c0 <= up) ? p0[r] : -1e30f; p1[r] = (c1 >= lo && c1 <= up) ? p1[r] : -1e30f; }
  }
  float rm = attn_body::rowmax(p0, p1);
  if (S == 0) {
    mrun = rm;
#pragma unroll
    for (int r = 0; r < 16; ++r) { p0[r] -= rm; p1[r] -= rm; negm[r] = -rm; }
  } else if (__any(rm > 8.f)) {
    const float dl = fmaxf(rm, 0.f); mrun += dl; const float alpha = __builtin_amdgcn_exp2f(-dl); lrun *= alpha;
#pragma unroll
    for (int r = 0; r < 16; ++r) { p0[r] -= dl; p1[r] -= dl; negm[r] = -mrun; }
    if (hi == 0) wsf[r32] = alpha;
    WIN_WAITL0();
#pragma unroll
    for (int r = 0; r < 16; ++r) { const float f = wsf[attn_body::crow(r, hi)]; o[0][r] *= f; o[1][r] *= f; }
  }
  float sA = 0.f, sB = 0.f;
#pragma unroll
  for (int r = 0; r < 16; ++r) { p0[r] = __builtin_amdgcn_exp2f(p0[r]); p1[r] = __builtin_amdgcn_exp2f(p1[r]); sA += p0[r]; sB += p1[r]; }
  lrun += sA + sB;
  u32x4 pw0, pw1, pw2, pw3;
#define WPK(P, B) attn_body::cvtpk_s(P[B], P[B + 1])
  pw0 = (u32x4){WPK(p0, 0), WPK(p0, 2), WPK(p0, 4), WPK(p0, 6)}; pw1 = (u32x4){WPK(p0, 8), WPK(p0, 10), WPK(p0, 12), WPK(p0, 14)};
  pw2 = (u32x4){WPK(p1, 0), WPK(p1, 2), WPK(p1, 4), WPK(p1, 6)}; pw3 = (u32x4){WPK(p1, 8), WPK(p1, 10), WPK(p1, 12), WPK(p1, 14)};
#undef WPK
  __builtin_amdgcn_sched_barrier(0);
  attn_body::pv(o, vb, __builtin_bit_cast(bf16x8, pw0), __builtin_bit_cast(bf16x8, pw1), __builtin_bit_cast(bf16x8, pw2), __builtin_bit_cast(bf16x8, pw3));
}
template <int HS> __device__ __forceinline__ void tile_half(const bf16x8* kf, const bf16x8* qr, f32x16* o, f32x16& negm, float& mrun, float& lrun, int k0, int qi, int L, int hi, int r32, int vb, volatile __attribute__((address_space(3))) float* wsf) {
  f32x16 p = __builtin_amdgcn_mfma_f32_32x32x16_bf16(kf[HS], qr[0], negm, 0, 0, 0);
#pragma unroll
  for (int d0 = 1; d0 < 4; ++d0) p = __builtin_amdgcn_mfma_f32_32x32x16_bf16(kf[2 * d0 + HS], qr[d0], p, 0, 0, 0);
  { const int dlt = k0 - qi; int lo = (-64 - dlt) > (-k0) ? (-64 - dlt) : (-k0); int up = (64 - dlt) < (L - 1 - k0) ? (64 - dlt) : (L - 1 - k0); lo -= 4 * hi; up -= 4 * hi;
#pragma unroll
    for (int r = 0; r < 16; ++r) { const int c = (r & 3) + 8 * (r >> 2) + 32 * HS; p[r] = (c >= lo && c <= up) ? p[r] : -1e30f; } }
  float rm = fmaxf(fmaxf(p[0], p[1]), p[2]);
#pragma unroll
  for (int r = 3; r < 15; r += 2) rm = fmaxf(fmaxf(rm, p[r]), p[r + 1]);
  rm = fmaxf(rm, p[15]);
  { auto rr = __builtin_amdgcn_permlane32_swap(__float_as_uint(rm), __float_as_uint(rm), false, false); rm = fmaxf(__uint_as_float(rr[0]), __uint_as_float(rr[1])); }
  if (__any(rm > 8.f)) {
    const float dl = fmaxf(rm, 0.f); mrun += dl; const float alpha = __builtin_amdgcn_exp2f(-dl); lrun *= alpha;
#pragma unroll
    for (int r = 0; r < 16; ++r) { p[r] -= dl; negm[r] = -mrun; }
    if (hi == 0) wsf[r32] = alpha;
    WIN_WAITL0();
#pragma unroll
    for (int r = 0; r < 16; ++r) { const float f = wsf[attn_body::crow(r, hi)]; o[0][r] *= f; o[1][r] *= f; }
  }
  float sA = 0.f;
#pragma unroll
  for (int r = 0; r < 16; ++r) { p[r] = __builtin_amdgcn_exp2f(p[r]); sA += p[r]; }
  lrun += sA;
  u32x4 pwA, pwB;
#define WPK(P, B) attn_body::cvtpk_s(P[B], P[B + 1])
  pwA = (u32x4){WPK(p, 0), WPK(p, 2), WPK(p, 4), WPK(p, 6)}; pwB = (u32x4){WPK(p, 8), WPK(p, 10), WPK(p, 12), WPK(p, 14)};
#undef WPK
  __builtin_amdgcn_sched_barrier(0);
#pragma unroll
  for (int d0 = 0; d0 < 2; ++d0) { s16x4 lo0, hi0, lo1, hi1;
    asm volatile("ds_read_b64_tr_b16 %0,%1 offset:%c2" : "=&v"(lo0) : "v"(vb), "i"(d0 * 4096 + (2 * HS) * 1024) : "memory");
    asm volatile("ds_read_b64_tr_b16 %0,%1 offset:%c2" : "=&v"(hi0) : "v"(vb), "i"(d0 * 4096 + (2 * HS) * 1024 + 512) : "memory");
    asm volatile("ds_read_b64_tr_b16 %0,%1 offset:%c2" : "=&v"(lo1) : "v"(vb), "i"(d0 * 4096 + (2 * HS + 1) * 1024) : "memory");
    asm volatile("ds_read_b64_tr_b16 %0,%1 offset:%c2" : "=&v"(hi1) : "v"(vb), "i"(d0 * 4096 + (2 * HS + 1) * 1024 + 512) : "memory");
    asm volatile("s_waitcnt lgkmcnt(0)" ::: "memory"); __builtin_amdgcn_sched_barrier(0);
    o[d0] = __builtin_amdgcn_mfma_f32_32x32x16_bf16(__builtin_bit_cast(bf16x8, pwA), (bf16x8){lo0[0], lo0[1], lo0[2], lo0[3], hi0[0], hi0[1], hi0[2], hi0[3]}, o[d0], 0, 0, 0);
    o[d0] = __builtin_amdgcn_mfma_f32_32x32x16_bf16(__builtin_bit_cast(bf16x8, pwB), (bf16x8){lo1[0], lo1[1], lo1[2], lo1[3], hi1[0], hi1[1], hi1[2], hi1[3]}, o[d0], 0, 0, 0);
  }
}
__device__ __forceinline__ void win_unit(int b, int h, int ld, int c, int I0, const bf16* QA, const bf16* KA, const bf16* VA, bf16* OA, float* LSE, lptr Lb, volatile __attribute__((address_space(3))) float* wsf, int lane, int wid) {
  const int r32 = lane & 31, hi = lane >> 5; const int L = 4096 >> ld; const long rowbase = (long)b * 4096;
  const bf16* Kc = KA + (rowbase + c) * 512 + h * 64; const bf16* Vc = VA + (rowbase + c) * 512 + h * 64;
  const unsigned lbase = (unsigned)(uintptr_t)Lb;
  for (int dupl_ = 0; dupl_ < ((PROBE_DUP & 4096) ? 2 : 1); ++dupl_) {
  if (dupl_) { WIN_WAITV0(); __syncthreads(); }
#pragma unroll
  for (int kt = 0; kt < 6; ++kt) { const int key = clampi(I0 - 64 + 64 * kt + lane, 0, L - 1);
    attn_body::glds16(Kc + ((long)key << ld) * 512 + wid * 8, (unsigned)__builtin_amdgcn_readfirstlane(lbase + kt * 8192 + wid * 1024)); }
#pragma unroll
  for (int kt = 0; kt < 6; ++kt) { const int key = clampi(I0 - 64 + 64 * kt + 16 * (wid & 3) + (lane >> 2), 0, L - 1);
    attn_body::glds16(Vc + ((long)key << ld) * 512 + (wid >> 2) * 32 + (lane & 3) * 8, (unsigned)__builtin_amdgcn_readfirstlane(lbase + 49152 + kt * 8192 + wid * 1024)); }
  }
  const int i0 = I0 + 32 * wid, qi = i0 + r32;
  const bf16* Qrow = QA + (rowbase + ((long)qi << ld) + c) * 512 + h * 64 + hi * 8;
  bf16x8 qr[4];
#pragma unroll
  for (int d0 = 0; d0 < 4; ++d0) qr[d0] = *reinterpret_cast<const bf16x8*>(Qrow + d0 * 16);
  f32x16 o[2]; o[0] = f32x16{}; o[1] = f32x16{}; float mrun = -1e30f, lrun = 0.f;
  const int vb0 = (int)lbase + 49152 + ((lane >> 4) & 1) * 32 + (lane & 3) * 8 + (4 * hi + ((lane & 15) >> 2)) * 64;
  WIN_WAITV0(); __syncthreads();
  const int tb = wid >> 1;
  f32x16 negm = f32x16{};
#define WIN_KF(kt_) bf16x8 kf[8]; { const lptr kp = Lb + (kt_) * 8192 + hi * 1024 + r32 * 16; _Pragma("unroll") for (int j = 0; j < 4; ++j) { kf[2 * j] = *(const __attribute__((address_space(3))) bf16x8*)(kp + j * 2048); kf[2 * j + 1] = *(const __attribute__((address_space(3))) bf16x8*)(kp + j * 2048 + 512); } }
  { const int kt = tb + 1; WIN_KF(kt) tile_step2<0>(kf, qr, o, negm, mrun, lrun, I0 - 64 + 64 * kt, qi, L, hi, r32, vb0 + kt * 8192, wsf); }
  if ((wid & 1) == 0) {
    { const int kt = tb;     WIN_KF(kt) tile_step2<1>(kf, qr, o, negm, mrun, lrun, I0 - 64 + 64 * kt, qi, L, hi, r32, vb0 + kt * 8192, wsf); }
    { const int kt = tb + 2; WIN_KF(kt) tile_half<0>(kf, qr, o, negm, mrun, lrun, I0 - 64 + 64 * kt, qi, L, hi, r32, vb0 + kt * 8192, wsf); }
  } else {
    { const int kt = tb;     WIN_KF(kt) tile_half<1>(kf, qr, o, negm, mrun, lrun, I0 - 64 + 64 * kt, qi, L, hi, r32, vb0 + kt * 8192, wsf); }
    { const int kt = tb + 2; WIN_KF(kt) tile_step2<2>(kf, qr, o, negm, mrun, lrun, I0 - 64 + 64 * kt, qi, L, hi, r32, vb0 + kt * 8192, wsf); }
  }
#undef WIN_KF
  { auto rr = __builtin_amdgcn_permlane32_swap(__float_as_uint(lrun), __float_as_uint(lrun), false, false); lrun = __uint_as_float(rr[0]) + __uint_as_float(rr[1]); }
  const long tok = rowbase + ((long)qi << ld) + c;
  if (hi == 0) { wsf[32 + r32] = lrun; LSE[tok * 8 + h] = mrun + __builtin_amdgcn_logf(lrun); }
  WIN_WAITL0();
  __attribute__((address_space(3))) unsigned short* stg = (__attribute__((address_space(3))) unsigned short*)(Lb + 98304 + wid * 4096);
#pragma unroll
  for (int r = 0; r < 16; ++r) { const int orow = attn_body::crow(r, hi); const float rl = __builtin_amdgcn_rcpf(wsf[32 + orow]);
#pragma unroll
    for (int d0 = 0; d0 < 2; ++d0) stg[orow * 64 + d0 * 32 + r32] = (unsigned short)(attn_body::cvtpk_s(o[d0][r] * rl, 0.f) & 0xffffu); }
  WIN_WAITL0();
#pragma unroll
  for (int i = 0; i < 4; ++i) { const int row = i * 8 + (lane >> 3), ch = lane & 7; const u32x4 v = *(const __attribute__((address_space(3))) u32x4*)(stg + row * 64 + ch * 8);
    *(u32x4*)(OA + (rowbase + ((long)(i0 + row) << ld) + c) * 512 + h * 64 + ch * 8) = v; }
  WIN_WAITL0(); __syncthreads();
}
struct WU { int b, h, ld, c, I0, p; };
__device__ __forceinline__ WU win_decode(int it) { WU w; const int blk = it & 15, rest = it >> 4; w.p = rest % 3; w.h = (rest / 3) & 7; w.b = rest / 24; w.ld = 2 * w.p; const int u = blk * 256; w.c = u >> (12 - w.ld); w.I0 = u & ((4096 >> w.ld) - 1); return w; }
__device__ __forceinline__ void win_issue(const WU& w, const bf16* QA, const bf16* KA, const bf16* VA, unsigned lbase, int lane, int wid, bf16x8* qr) {
  const int r32 = lane & 31, hi = lane >> 5; const int L = 4096 >> w.ld; const long rowbase = (long)w.b * 4096;
  const bf16* Kc = KA + (rowbase + w.c) * 512 + w.h * 64; const bf16* Vc = VA + (rowbase + w.c) * 512 + w.h * 64;
#pragma unroll
  for (int kt = 0; kt < 6; ++kt) { const int key = clampi(w.I0 - 64 + 64 * kt + lane, 0, L - 1);
    attn_body::glds16(Kc + ((long)key << w.ld) * 512 + wid * 8, (unsigned)__builtin_amdgcn_readfirstlane(lbase + kt * 8192 + wid * 1024)); }
#pragma unroll
  for (int kt = 0; kt < 6; ++kt) { const int key = clampi(w.I0 - 64 + 64 * kt + 16 * (wid & 3) + (lane >> 2), 0, L - 1);
    attn_body::glds16(Vc + ((long)key << w.ld) * 512 + (wid >> 2) * 32 + (lane & 3) * 8, (unsigned)__builtin_amdgcn_readfirstlane(lbase + 49152 + kt * 8192 + wid * 1024)); }
  const int qi = w.I0 + 32 * wid + r32;
  const bf16* Qrow = QA + (rowbase + ((long)qi << w.ld) + w.c) * 512 + w.h * 64 + hi * 8;
#pragma unroll
  for (int d0 = 0; d0 < 4; ++d0) qr[d0] = *reinterpret_cast<const bf16x8*>(Qrow + d0 * 16);
}
__device__ __forceinline__ void win_phase(int vcu, int G, int bx, const bf16* QA, const bf16* KA, const bf16* VA, bf16* OAb, float* LSEb, lptr Lb, volatile __attribute__((address_space(3))) float* wsf, int lane, int wid, unsigned* qctr) {
  constexpr int NUN = 81920 / 256 * 8 * 3;
  const int r32 = lane & 31, hi = lane >> 5; const unsigned lbase = (unsigned)(uintptr_t)Lb;
  const bool g256 = (G == 256);
#define WIN_IT(i_) (g256 ? (((vcu >> 5) * 20 + 2 * ((i_) / 3)) * 48 + (vcu & 31) * 3 + ((i_) % 3)) : (bx + (i_) * G))
  volatile __attribute__((address_space(3))) int* qslot = (volatile __attribute__((address_space(3))) int*)(Lb + 131072 + 64);
  const int qbase = (vcu >> 5) * 960; unsigned* myq = qctr + (vcu >> 5) * 64;
  int it;
  if (g256) { if (wid == 0 && lane == 0) qslot[0] = (int)__hip_atomic_fetch_add(myq, 1u, __ATOMIC_RELAXED, __HIP_MEMORY_SCOPE_AGENT);
    __syncthreads(); const int q0_ = __builtin_amdgcn_readfirstlane(qslot[0]); if (q0_ >= 960) return; it = qbase + q0_; }
  else { it = WIN_IT(0); if (it >= NUN) return; }
  WU cur = win_decode(it); bf16x8 qr[4]; win_issue(cur, QA, KA, VA, lbase, lane, wid, qr);
  const int vb0 = (int)lbase + 49152 + ((lane >> 4) & 1) * 32 + (lane & 3) * 8 + (4 * hi + ((lane & 15) >> 2)) * 64;
  const int tb = wid >> 1;
  for (int i = 0;; ++i) {
    int itn = g256 ? 0 : WIN_IT(i + 1); bool has_next = g256 ? false : (itn < NUN);
    const int ld = cur.ld, L = 4096 >> ld, I0 = cur.I0; const long rowbase = (long)cur.b * 4096; const int i0 = I0 + 32 * wid, qi = i0 + r32;
    asm volatile("s_waitcnt vmcnt(0) lgkmcnt(0)" ::: "memory"); __builtin_amdgcn_s_barrier(); asm volatile("" ::: "memory");
    int tick_ = 0; if (g256 && wid == 0 && lane == 0) tick_ = (int)__hip_atomic_fetch_add(myq, 1u, __ATOMIC_RELAXED, __HIP_MEMORY_SCOPE_AGENT);
    f32x16 o[2]; o[0] = f32x16{}; o[1] = f32x16{}; float mrun = -1e30f, lrun = 0.f; f32x16 negm = f32x16{};
#define WIN_KF(kt_) bf16x8 kf[8]; { const lptr kp = Lb + (kt_) * 8192 + hi * 1024 + r32 * 16; _Pragma("unroll") for (int j = 0; j < 4; ++j) { kf[2 * j] = *(const __attribute__((address_space(3))) bf16x8*)(kp + j * 2048); kf[2 * j + 1] = *(const __attribute__((address_space(3))) bf16x8*)(kp + j * 2048 + 512); } }
    { const int kt = tb + 1; WIN_KF(kt) tile_step2<0>(kf, qr, o, negm, mrun, lrun, I0 - 64 + 64 * kt, qi, L, hi, r32, vb0 + kt * 8192, wsf); }
    if ((wid & 1) == 0) {
      { const int kt = tb;     WIN_KF(kt) tile_step2<1>(kf, qr, o, negm, mrun, lrun, I0 - 64 + 64 * kt, qi, L, hi, r32, vb0 + kt * 8192, wsf); }
      { const int kt = tb + 2; WIN_KF(kt) tile_half<0>(kf, qr, o, negm, mrun, lrun, I0 - 64 + 64 * kt, qi, L, hi, r32, vb0 + kt * 8192, wsf); }
    } else {
      { const int kt = tb;     WIN_KF(kt) tile_half<1>(kf, qr, o, negm, mrun, lrun, I0 - 64 + 64 * kt, qi, L, hi, r32, vb0 + kt * 8192, wsf); }
      { const int kt = tb + 2; WIN_KF(kt) tile_step2<2>(kf, qr, o, negm, mrun, lrun, I0 - 64 + 64 * kt, qi, L, hi, r32, vb0 + kt * 8192, wsf); }
    }
#undef WIN_KF
    if (g256 && wid == 0 && lane == 0) qslot[(i + 1) & 1] = tick_;
    asm volatile("s_waitcnt lgkmcnt(0)" ::: "memory"); __builtin_amdgcn_s_barrier(); asm volatile("" ::: "memory");
    if (g256) { const int qn_ = __builtin_amdgcn_readfirstlane(qslot[(i + 1) & 1]); has_next = qn_ < 960; itn = qbase + qn_; }
    WU nxt = cur;
    if (has_next) { nxt = win_decode(itn); win_issue(nxt, QA, KA, VA, lbase, lane, wid, qr); }
    bf16* OA = OAb + (size_t)cur.p * 81920 * 512; float* LSE = LSEb + (size_t)cur.p * 81920 * 8; const int h = cur.h, c = cur.c;
    { auto rr = __builtin_amdgcn_permlane32_swap(__float_as_uint(lrun), __float_as_uint(lrun), false, false); lrun = __uint_as_float(rr[0]) + __uint_as_float(rr[1]); }
    const long tok = rowbase + ((long)qi << ld) + c;
    if (hi == 0) { wsf[32 + r32] = lrun; LSE[tok * 8 + h] = mrun + __builtin_amdgcn_logf(lrun); }
    WIN_WAITL0();
    __attribute__((address_space(3))) unsigned short* stg = (__attribute__((address_space(3))) unsigned short*)(Lb + 98304 + wid * 4096);
#pragma unroll
    for (int r = 0; r < 16; ++r) { const int orow = attn_body::crow(r, hi); const float rl = __builtin_amdgcn_rcpf(wsf[32 + orow]);
#pragma unroll
      for (int d0 = 0; d0 < 2; ++d0) stg[orow * 64 + d0 * 32 + r32] = (unsigned short)(attn_body::cvtpk_s(o[d0][r] * rl, 0.f) & 0xffffu); }
    WIN_WAITL0();
#pragma unroll
    for (int q = 0; q < 4; ++q) { const int row = q * 8 + (lane >> 3), ch = lane & 7; const u32x4 v = *(const __attribute__((address_space(3))) u32x4*)(stg + row * 64 + ch * 8);
      *(u32x4*)(OA + (rowbase + ((long)(i0 + row) << ld) + c) * 512 + h * 64 + ch * 8) = v; }
    WIN_WAITL0();
    if (!has_next) break;
    cur = nxt; it = itn;
  }
}
}

namespace cg = cooperative_groups;
using pg8::NSEQ; using pg8::SEQL; using pg8::TOK; using pg8::DM_; using pg8::NPROMPT_TOK; using pg8::ATTN_IN_W; using pg8::MiB; using pg8::WS_MOD; using pg8::WS_TAB; using pg8::WS_W; using pg8::WS_LSE; using pg8::WS_H; using pg8::WS_SG; using pg8::WS_QA; using pg8::WS_KA; using pg8::WS_VA; using pg8::WS_QB; using pg8::WS_KB; using pg8::WS_VB; using pg8::WS_OA; using pg8::WS_END; using pg8::WO_AIN; using pg8::WO_AOUT; using pg8::WO_PIN; using pg8::WO_GRP; using pg8::WO_POUT;
#define LAS __attribute__((address_space(3)))
typedef unsigned short bf16u;
typedef float f32x4 __attribute__((ext_vector_type(4)));
typedef unsigned v4u __attribute__((ext_vector_type(4)));
typedef unsigned v2u __attribute__((ext_vector_type(2)));
#define XB_TMO      128
#define XB_XCNT(j)  (256  + 64 * (j))
#define XB_XSUB(j)  (1280 + 64 * (j))
#define XB_XGEN(j)  (2304 + 64 * (j))
#define XB_TOP      3328
#define XB_TOPGEN   3392
#define XCD_BAR_WORDS 3456
#define XB_SPIN_CAP (1u << 18)

__device__ __forceinline__ unsigned xb_ld(unsigned* p)              { return __hip_atomic_load(p, __ATOMIC_RELAXED, __HIP_MEMORY_SCOPE_AGENT); }
__device__ __forceinline__ unsigned xb_add(unsigned* p, unsigned v) { return __hip_atomic_fetch_add(p, v, __ATOMIC_RELAXED, __HIP_MEMORY_SCOPE_AGENT); }
__device__ __forceinline__ unsigned xb_xcc_id() { return (unsigned)__builtin_amdgcn_s_getreg((3 << 11) | 20) & 0xFu; }
#define XB_SPIN(cond, bar) do { unsigned _sp = 0; while (cond) { __builtin_amdgcn_s_sleep(1); \
    if ((++_sp & 255u) == 0u) { if (xb_ld(&(bar)[XB_TMO])) break; if (_sp > XB_SPIN_CAP) { atomicAdd(&(bar)[XB_TMO], 1u); break; } } } } while (0)

struct XcdBarrier {
    unsigned* bar; unsigned x;
    volatile LAS unsigned* st;
};

__device__ __forceinline__ XcdBarrier xcd_barrier_post(unsigned* bar, volatile LAS unsigned* st) {
    XcdBarrier b; b.bar = bar; b.x = xb_xcc_id(); b.st = st;
    if (threadIdx.x == 0) (void)xb_add(&bar[XB_XCNT(b.x)], 1u);
    return b;
}
__device__ __forceinline__ void xcd_barrier_complete(unsigned* bar, unsigned x, unsigned& nloc, unsigned& nx) {
    const unsigned G = gridDim.x * gridDim.y * gridDim.z;
    unsigned sum, cnt, mine, sp = 0u;
    for (;;) {
        sum = 0u; cnt = 0u; mine = 0u;
#pragma unroll
        for (unsigned j = 0; j < 16; ++j) { const unsigned c = xb_ld(&bar[XB_XCNT(j)]); sum += c; cnt += (c > 0u) ? 1u : 0u; mine = (j == x) ? c : mine; }
        if (sum == G) break;
        __builtin_amdgcn_s_sleep(1);
        if ((++sp & 255u) == 0u) { if (xb_ld(&bar[XB_TMO])) break; if (sp > XB_SPIN_CAP) { atomicAdd(&bar[XB_TMO], 1u); break; } }
    }
    nloc = mine > 0u ? mine : 1u; nx = cnt > 0u ? cnt : 1u;
}

__device__ __forceinline__ void xcd_barrier(const XcdBarrier& b) {
    asm volatile("s_waitcnt vmcnt(0)" ::: "memory");
    __syncthreads();
    if (threadIdx.x == 0) {
        unsigned* bar = b.bar;
        __builtin_amdgcn_s_waitcnt(0);
        unsigned nloc = b.st[0], nx = b.st[1];
        if (nloc == 0u) { xcd_barrier_complete(bar, b.x, nloc, nx); b.st[0] = nloc; b.st[1] = nx; }
        const unsigned old = xb_add(&bar[XB_XSUB(b.x)], 1u);
        const unsigned gen = old / nloc;
        if (old + 1u == (gen + 1u) * nloc) {
            __builtin_amdgcn_fence(__ATOMIC_RELEASE, "agent");
            asm volatile("s_waitcnt vmcnt(0)" ::: "memory");
            const unsigned og = xb_add(&bar[XB_TOP], 1u);
            const unsigned tg = og / nx;
            if (og + 1u == (tg + 1u) * nx) xb_add(&bar[XB_TOPGEN], 1u);
            else XB_SPIN(xb_ld(&bar[XB_TOPGEN]) == tg, bar);
            __builtin_amdgcn_fence(__ATOMIC_ACQUIRE, "agent");
            xb_add(&bar[XB_XGEN(b.x)], 1u);
            asm volatile("s_waitcnt vmcnt(0)" ::: "memory");
        } else {
            XB_SPIN(xb_ld(&bar[XB_XGEN(b.x)]) == gen, bar);
            __builtin_amdgcn_fence(__ATOMIC_ACQUIRE, "agent");
            asm volatile("s_waitcnt vmcnt(0)" ::: "memory");
        }
    }
    __syncthreads();
}

constexpr int RING_BYTES = 131072, LDS_BYTES = 147456, WSF_OFF = RING_BYTES + 512, BARLDS_OFF = WSF_OFF + 8 * 256;
constexpr size_t WS_BAR = WS_MOD + 983040;

__device__ __forceinline__ unsigned f2bf(float f) { unsigned u = __builtin_bit_cast(unsigned, f); return (u + 0x7fffu + ((u >> 16) & 1u)) >> 16; }
__device__ __forceinline__ unsigned pk2(float lo, float hi) { return f2bf(lo) | (f2bf(hi) << 16); }
__device__ __forceinline__ float bflo(unsigned w) { return __uint_as_float(w << 16); }
__device__ __forceinline__ float bfhi(unsigned w) { return __uint_as_float(w & 0xffff0000u); }
__device__ __forceinline__ int opq(int x) { asm volatile("" : "+v"(x)); return x; }
__device__ __forceinline__ float wave_sum(float v) {
#pragma unroll
  for (int o = 1; o < 64; o <<= 1) v += __shfl_xor(v, o);
  return v;
}
__device__ __forceinline__ void transpose_item(const float* W, int K, int N, bf16u* WT, int row_off, LAS float* scr, int item, int lane, bool perm) {
  const int nblk = N / 32, kb = item / nblk, nb = item % nblk, k0 = 64 * kb, n0 = 32 * nb;
#pragma unroll 8
  for (int i = 0; i < 32; ++i) { const int kk = 2 * i + (lane >> 5); scr[kk * 33 + (lane & 31)] = W[(size_t)(k0 + kk) * N + n0 + (lane & 31)]; }
  asm volatile("s_waitcnt lgkmcnt(0)" ::: "memory");
  const int c = lane & 7;
  const int n0d = perm ? ((n0 & ~255) + 128 * ((n0 >> 5) & 1) + 32 * ((n0 >> 6) & 3)) : n0;
#pragma unroll
  for (int j = 0; j < 4; ++j) { const int n = (lane >> 3) + 8 * j; const LAS float* s = scr + (8 * c) * 33 + n;
    v4u o; o.x = pk2(s[0 * 33], s[1 * 33]); o.y = pk2(s[2 * 33], s[3 * 33]); o.z = pk2(s[4 * 33], s[5 * 33]); o.w = pk2(s[6 * 33], s[7 * 33]);
    *(v4u*)(WT + (size_t)(row_off + n0d + n) * K + k0 + 8 * c) = o; }
  asm volatile("s_waitcnt lgkmcnt(0)" ::: "memory");
}
__device__ __forceinline__ void prenorm_store(const f32x4 (&v)[4], const float* pre, const float* mod, bf16u* hrow, int lane) {
  float ss = 0.f;
#pragma unroll
  for (int j = 0; j < 4; ++j) ss += (v[j].x * v[j].x + v[j].y * v[j].y) + (v[j].z * v[j].z + v[j].w * v[j].w);
  const float rinv = rsqrtf(wave_sum(ss) * (1.f / 1024.f) + 1e-6f);
#pragma unroll
  for (int j = 0; j < 4; ++j) { const int c = 256 * j + 4 * lane; const f32x4 g = *(const f32x4*)(pre + c), sh = *(const f32x4*)(mod + c), sc = *(const f32x4*)(mod + 1024 + c);
    const f32x4 hval = v[j] * rinv * g * (sc + 1.f) + sh; v2u o; o.x = pk2(hval.x, hval.y); o.y = pk2(hval.z, hval.w); *(v2u*)(hrow + c) = o; }
}

__device__ __forceinline__ void post_phase(int l, bool do_next, const float* x_p, const float* x_s, float* out, const bf16u* Mo, const float* MOD, const float* post_norm, const float* pre_norm, bf16u* H, int gw, int NGW, int lane) {
  const int wpb = NGW / NSEQ; if (gw >= wpb * NSEQ) return;
  const int b = gw / wpb, j0 = gw - b * wpb;
  f32x4 gp[4], g1[4], sh[4];
  { const float* md = MOD + ((size_t)l * NSEQ + b) * 3072; const float* mn = MOD + ((size_t)(l + 1) * NSEQ + b) * 3072;
#pragma unroll
    for (int j = 0; j < 4; ++j) { const int c = 256 * j + 4 * lane; gp[j] = *(const f32x4*)(post_norm + l * 1024 + c) * *(const f32x4*)(md + 2048 + c);
      if (do_next) { g1[j] = *(const f32x4*)(pre_norm + (l + 1) * 1024 + c) * (*(const f32x4*)(mn + 1024 + c) + 1.f); sh[j] = *(const f32x4*)(mn + c); } else { g1[j] = (f32x4){0.f, 0.f, 0.f, 0.f}; sh[j] = g1[j]; } } }
#define POST_LOAD(XV, MW, R0) do { const int mA_ = b * SEQL + (R0), mB_ = ((R0) + wpb) < SEQL ? mA_ + wpb : mA_; \
    _Pragma("unroll") for (int r = 0; r < 2; ++r) { const int m = r ? mB_ : mA_; const float* xr = (l == 0) ? ((m < NPROMPT_TOK) ? x_p + (size_t)m * 1024 : x_s + (size_t)(m - NPROMPT_TOK) * 1024) : out + (size_t)m * 1024; \
      _Pragma("unroll") for (int j = 0; j < 4; ++j) { XV[r][j] = *(const f32x4*)(xr + 256 * j + 4 * lane); MW[r][j] = *(const v2u*)(Mo + (size_t)m * 1024 + 256 * j + 4 * lane); } } } while (0)
  f32x4 xv[2][4]; v2u mw[2][4];
  if (j0 < SEQL) POST_LOAD(xv, mw, j0);
  for (int r0 = j0; r0 < SEQL; r0 += 2 * wpb) {
    const bool ok1 = (r0 + wpb) < SEQL; const int mA = b * SEQL + r0, mB = ok1 ? mA + wpb : mA;
    f32x4 xn_[2][4]; v2u mn_[2][4]; const int rn = r0 + 2 * wpb; const bool more = rn < SEQL;
    if (more) POST_LOAD(xn_, mn_, rn);
#pragma unroll
    for (int r = 0; r < 2; ++r) { const int m = r ? mB : mA; f32x4 mv[4]; float ss = 0.f;
#pragma unroll
      for (int j = 0; j < 4; ++j) { const v2u w = mw[r][j]; mv[j] = (f32x4){bflo(w.x), bfhi(w.x), bflo(w.y), bfhi(w.y)}; ss += (mv[j].x * mv[j].x + mv[j].y * mv[j].y) + (mv[j].z * mv[j].z + mv[j].w * mv[j].w); }
      const float rinv = rsqrtf(wave_sum(ss) * (1.f / 1024.f) + 1e-6f);
      if (r == 0 || ok1) {
        float s2 = 0.f;
#pragma unroll
        for (int j = 0; j < 4; ++j) { const int c = 256 * j + 4 * lane; const f32x4 xn = xv[r][j] + gp[j] * (mv[j] * rinv); xv[r][j] = xn; *(f32x4*)(out + (size_t)m * 1024 + c) = xn;
          s2 += (xn.x * xn.x + xn.y * xn.y) + (xn.z * xn.z + xn.w * xn.w); }
        if (do_next) { const float r2 = rsqrtf(wave_sum(s2) * (1.f / 1024.f) + 1e-6f);
#pragma unroll
          for (int j = 0; j < 4; ++j) { const int c = 256 * j + 4 * lane; const f32x4 hval = xv[r][j] * r2 * g1[j] + sh[j]; v2u o; o.x = pk2(hval.x, hval.y); o.y = pk2(hval.z, hval.w); *(v2u*)(H + (size_t)m * 1024 + c) = o; } }
      }
    }
    if (more) {
#pragma unroll
      for (int r = 0; r < 2; ++r)
#pragma unroll
        for (int j = 0; j < 4; ++j) { xv[r][j] = xn_[r][j]; mw[r][j] = mn_[r][j]; } }
  }
#undef POST_LOAD
}
#define PH_VARS \
  ArgsP ap = argp(); unsigned char* ws = GPTR(unsigned char, ap->ws); float* out = GPTR(float, ap->out); (void)out; \
  const float *x_p = GPTR(const float, ap->in[0]), *x_s = GPTR(const float, ap->in[1]), *c_p = GPTR(const float, ap->in[2]), *c_s = GPTR(const float, ap->in[3]), *ada_w = GPTR(const float, ap->in[4]), *ada_b = GPTR(const float, ap->in[5]), *pre_norm = GPTR(const float, ap->in[6]), *post_norm = GPTR(const float, ap->in[7]), *attn_w_in = GPTR(const float, ap->in[8]), *attn_qn = GPTR(const float, ap->in[9]), *attn_kn = GPTR(const float, ap->in[10]), \
              *attn_w_out = GPTR(const float, ap->in[11]), *pool_w_in = GPTR(const float, ap->in[12]), *pool_w_grp = GPTR(const float, ap->in[13]), *pool_scale = GPTR(const float, ap->in[14]), *pool_w_out = GPTR(const float, ap->in[15]); \
  (void)x_p; (void)x_s; (void)c_p; (void)c_s; (void)ada_w; (void)ada_b; (void)pre_norm; (void)post_norm; (void)attn_w_in; (void)attn_qn; (void)attn_kn; (void)attn_w_out; (void)pool_w_in; (void)pool_w_grp; (void)pool_scale; (void)pool_w_out; \
  float* ropeA = (float*)(ws + WS_TAB); float* ropeX = ropeA + 4096 * 16; float* MOD = (float*)(ws + WS_MOD); (void)ropeX; (void)MOD; \
  bf16u* Wb = (bf16u*)(ws + WS_W); (void)Wb; \
  bf16u *H = (bf16u*)(ws + WS_H), *SG = (bf16u*)(ws + WS_SG), *QA = (bf16u*)(ws + WS_QA), *KA = (bf16u*)(ws + WS_KA), *VA = (bf16u*)(ws + WS_VA), *QB = (bf16u*)(ws + WS_QB), *KB = (bf16u*)(ws + WS_KB), *VB = (bf16u*)(ws + WS_VB), \
        *OA = (bf16u*)(ws + WS_OA); \
  bf16u *Y = H, *Mo = QA, *U = QA, *PO = VA; float* LSE = (float*)(ws + WS_LSE); \
  (void)H; (void)SG; (void)QA; (void)KA; (void)VA; (void)QB; (void)KB; (void)VB; (void)OA; (void)Y; (void)Mo; (void)U; (void)PO; (void)LSE;

__global__ void __launch_bounds__(512, 2) fwd_mega(Args a) {
  extern __shared__ __attribute__((aligned(16))) unsigned char lds[];
  cg::grid_group grid = cg::this_grid();
  const int tid = threadIdx.x, lane = tid & 63, wave = __builtin_amdgcn_readfirstlane(tid >> 6);
  const int G = gridDim.x, bx = blockIdx.x; const int vcu = (G % 8 == 0) ? (bx % 8) * (G / 8) + bx / 8 : bx;
  const int gw = vcu * 8 + wave, NGW = G * 8;
  LAS unsigned char* L = (LAS unsigned char*)lds;
  if (tid < 2) ((volatile LAS unsigned*)(L + BARLDS_OFF))[tid] = 0u;
  __syncthreads();
  { ArgsP ap0 = argp(); (void)xcd_barrier_post((unsigned*)(GPTR(unsigned char, ap0->ws) + WS_BAR), (volatile LAS unsigned*)(L + BARLDS_OFF)); }
#define GRID_BAR() do { ArgsP apb = argp(); XcdBarrier xb_; xb_.bar = (unsigned*)(GPTR(unsigned char, apb->ws) + WS_BAR); xb_.x = xb_xcc_id(); xb_.st = (volatile LAS unsigned*)(L + BARLDS_OFF); xcd_barrier(xb_); } while (0)

  {
    PH_VARS
    LAS float* scr = (LAS float*)(L + wave * 16384);
    constexpr int I_AIN = 16 * 104, I_AOUT = 16 * 32, I_PIN = 16 * 64, I_GRP = 4 * 8, I_POUT = 16 * 32;
    constexpr int NIT = 2 * I_AIN + 2 * I_AOUT + 2 * I_PIN + 8 * I_GRP + 2 * I_POUT;
    for (int dup_ = 0; dup_ < ((PROBE_DUP & 1024) ? 2 : 1); ++dup_)
    for (int it = gw; it < NIT; it += NGW) {
      int r = it;
      if (r < 2 * I_AIN) { const int i = r / I_AIN; transpose_item(attn_w_in + (size_t)i * 1024 * 3328, 1024, 3328, Wb + WO_AIN + (size_t)i * 3328 * 1024, 0, scr, r % I_AIN, lane, true); continue; } r -= 2 * I_AIN;
      if (r < 2 * I_AOUT) { const int i = r / I_AOUT; transpose_item(attn_w_out + (size_t)i * 1024 * 1024, 1024, 1024, Wb + WO_AOUT + (size_t)i * 1024 * 1024, 0, scr, r % I_AOUT, lane, false); continue; } r -= 2 * I_AOUT;
      if (r < 2 * I_PIN) { const int i = r / I_PIN; transpose_item(pool_w_in + (size_t)i * 1024 * 2048, 1024, 2048, Wb + WO_PIN + (size_t)i * 2048 * 1024, 0, scr, r % I_PIN, lane, false); continue; } r -= 2 * I_PIN;
      if (r < 8 * I_GRP) { const int ig = r / I_GRP; transpose_item(pool_w_grp + (size_t)ig * 65536, 256, 256, Wb + WO_GRP + (size_t)(ig >> 2) * 262144, (ig & 3) * 256, scr, r % I_GRP, lane, false); continue; } r -= 8 * I_GRP;
      { const int i = r / I_POUT; transpose_item(pool_w_out + (size_t)i * 1024 * 1024, 1024, 1024, Wb + WO_POUT + (size_t)i * 1024 * 1024, 0, scr, r % I_POUT, lane, false); }
    }
    for (int e = bx * 512 + tid; e < 4096 * 8 + 64 * 16; e += G * 512) {
      int pos, j; double inv; float* dstc; float* dsts;
      if (e < 4096 * 8) { pos = e >> 3; j = e & 7; inv = ap->invA[j]; dstc = ropeA + pos * 16 + j; dsts = dstc + 8; }
      else { const int f = e - 4096 * 8; pos = f >> 4; j = f & 15; inv = ap->invX[j]; dstc = ropeX + pos * 32 + j; dsts = dstc + 16; }
      const double rev = (double)pos * inv * 0.15915494309189535; const float fr = (float)(rev - __builtin_rint(rev));
      *dstc = __builtin_amdgcn_cosf(fr); *dsts = __builtin_amdgcn_sinf(fr);
    }
    __syncthreads();
    { LAS float* sc = (LAS float*)L;
      for (int e = tid; e < NSEQ * 1024; e += 512) { const int b = e >> 10, kk = e & 1023; const float cv = (b < 16) ? c_p[b * 1024 + kk] : c_s[(b - 16) * 1024 + kk]; sc[e] = pg8::silu_f(cv); }
      __syncthreads();
      for (int it = gw; it < 4 * 48 * 8; it += NGW) {
        const int kc = it & 7, nbk = (it >> 3) % 48, l = it / 384; const int n = nbk * 64 + lane;
        float acc[NSEQ];
#pragma unroll
        for (int b = 0; b < NSEQ; ++b) acc[b] = 0.f;
        const float* wp = ada_w + ((size_t)l * 1024 + kc * 128) * 3072 + n;
#pragma unroll 16
        for (int k = 0; k < 128; ++k) { const float w = wp[(size_t)k * 3072]; const int kk = kc * 128 + k;
#pragma unroll
          for (int b = 0; b < NSEQ; ++b) acc[b] += sc[b * 1024 + kk] * w; }
        const float bias = (kc == 0) ? ada_b[l * 3072 + n] : 0.f;
#pragma unroll
        for (int b = 0; b < NSEQ; ++b) atomicAdd(MOD + ((size_t)l * NSEQ + b) * 3072 + n, acc[b] + bias);
      }
    }
  }
  grid.sync();
  if (PROBE_DUP & 2048) { for (int q = 0; q < 20; ++q) GRID_BAR(); }
  for (int dup_ = 0; dup_ < ((PROBE_DUP & 512) ? 2 : 1); ++dup_) { PH_VARS
  for (int m0 = gw; m0 < TOK; m0 += 2 * NGW) {
    const bool ok1 = (m0 + NGW) < TOK; f32x4 v[2][4];
#pragma unroll
    for (int r = 0; r < 2; ++r) { const int m = (r && ok1) ? m0 + NGW : m0; const float* xr = (m < NPROMPT_TOK) ? x_p + (size_t)m * 1024 : x_s + (size_t)(m - NPROMPT_TOK) * 1024;
#pragma unroll
      for (int j = 0; j < 4; ++j) v[r][j] = *(const f32x4*)(xr + 256 * j + 4 * lane); }
#pragma unroll
    for (int r = 0; r < 2; ++r) { const int m = (r && ok1) ? m0 + NGW : m0; if (r == 0 || ok1) prenorm_store(v[r], pre_norm, MOD + (size_t)(m >> 12) * 3072, H + (size_t)m * 1024, lane); }
  } }
  GRID_BAR();

  for (int li = 0; li < 2; ++li) {
    {
      const int l = 2 * li;
      for (int dup_ = 0; dup_ < ((PROBE_DUP & 8) ? 2 : 1); ++dup_) { PH_VARS pg8::EpiP EP{li}; pg8::Gemm g{H, Wb + WO_AIN + (size_t)li * 3328 * 1024, TOK, ATTN_IN_W, 1024, 1024, 0}; pg8::StaticOrder S; S.init(TOK, ATTN_IN_W, G, bx);

#ifndef NO_G0
pg8::Epi<0> E{EP}; pg8::gemm_phase<pg8::Epi<0>, pg8::StaticOrder, true, true>(L, g, S, E);
#endif
 }
      GRID_BAR();
      for (int dup_ = 0; dup_ < ((PROBE_DUP & 1) ? 2 : 1); ++dup_) { PH_VARS const int nun = NSEQ * 8 * 16;
        { attn_body::bf16x8 qio[4]; bool pre = false;
        for (int i = 0;; ++i) {
          int b, h, qb, nb = 0, nh = 0, nqb = 0; bool has_next;
          if (G == 256) { if (i >= 10) break; const int xc = vcu >> 5, j = vcu & 31, pair = xc * 5 + (i >> 1), uip = (i & 1) * 32 + j; b = pair >> 1; h = (pair & 1) * 4 + (uip >> 4); qb = uip & 15;
            has_next = (i + 1 < 10); { const int i2 = i + 1, pair2 = xc * 5 + (i2 >> 1), uip2 = (i2 & 1) * 32 + j; nb = pair2 >> 1; nh = (pair2 & 1) * 4 + (uip2 >> 4); nqb = uip2 & 15; } }
          else { const int n = i * G + bx; if (n >= nun) break; b = n >> 7; h = (n >> 4) & 7; qb = n & 15; const int n2 = n + G; has_next = n2 < nun; nb = n2 >> 7; nh = (n2 >> 4) & 7; nqb = n2 & 15; }
#ifndef NO_DENSE
          attn_body::attn_unit<8>(b, h, qb, (const attn_body::bf16*)QB, (const attn_body::bf16*)KB, (const attn_body::bf16*)VB, (attn_body::bf16*)Y, (const attn_body::bf16*)SG, (char*)lds, pre, qio, has_next, nb, nh, nqb);
#endif
          pre = has_next;
        } }
      }
      __syncthreads();
      for (int dup_ = 0; dup_ < ((PROBE_DUP & 2) ? 2 : 1); ++dup_) { PH_VARS const int lane = opq(tid) & 63; win::lptr wl = (win::lptr)(L + wave * 16384); volatile LAS float* wsf = (volatile LAS float*)(L + WSF_OFF + wave * 256);
        win::win_phase(vcu, G, bx, (const win::bf16*)QA, (const win::bf16*)KA, (const win::bf16*)VA, (win::bf16*)OA, LSE, (win::lptr)L, wsf, lane, wave, (unsigned*)(ws + WS_BAR + 16384) + li * 8 * 64);
      }
      GRID_BAR();
      for (int dup_ = 0; dup_ < ((PROBE_DUP & 4) ? 2 : 1); ++dup_) { PH_VARS
      for (int m0 = gw; m0 < TOK; m0 += 2 * NGW) {
        const int lane = opq(tid) & 63; const int hh = lane >> 3; const bool ok1 = (m0 + NGW) < TOK;
        float ls[2][3]; v4u ov[2][3]; v4u gv[2];
#pragma unroll
        for (int r = 0; r < 2; ++r) { const int m = (r && ok1) ? m0 + NGW : m0;
#pragma unroll
          for (int p = 0; p < 3; ++p) { ls[r][p] = LSE[((size_t)p * TOK + m) * 8 + hh]; ov[r][p] = *(const v4u*)(OA + ((size_t)p * TOK + m) * 512 + 8 * lane); }
          gv[r] = *(const v4u*)(SG + (size_t)m * 1024 + 8 * lane); }
#pragma unroll
        for (int r = 0; r < 2; ++r) { const int m = (r && ok1) ? m0 + NGW : m0;
          const float mx = fmaxf(fmaxf(ls[r][0], ls[r][1]), ls[r][2]); float wsum = 0.f;
#pragma unroll
          for (int p = 0; p < 3; ++p) { ls[r][p] = __builtin_amdgcn_exp2f(ls[r][p] - mx); wsum += ls[r][p]; }
          const float rw = 1.f / wsum; float accv[8];
#pragma unroll
          for (int j = 0; j < 8; ++j) accv[j] = 0.f;
#pragma unroll
          for (int p = 0; p < 3; ++p) { const float wgt = ls[r][p] * rw;
#pragma unroll
            for (int q = 0; q < 4; ++q) { accv[2 * q] += wgt * bflo(ov[r][p][q]); accv[2 * q + 1] += wgt * bfhi(ov[r][p][q]); } }
          v4u o;
#pragma unroll
          for (int q = 0; q < 4; ++q) o[q] = pk2(accv[2 * q] * bflo(gv[r][q]), accv[2 * q + 1] * bfhi(gv[r][q]));
          if (r == 0 || ok1) *(v4u*)(Y + (size_t)m * 1024 + 8 * lane) = o;
        }
      } }
      GRID_BAR();
      for (int dup_ = 0; dup_ < ((PROBE_DUP & 32) ? 2 : 1); ++dup_) { PH_VARS pg8::EpiP EP{li}; pg8::Gemm g{Y, Wb + WO_AOUT + (size_t)li * 1024 * 1024, TOK, 1024, 1024, 1024, 0}; pg8::StaticOrder S; S.init(TOK, 1024, G, bx);

#ifndef NO_G3
pg8::Epi<3> E{EP}; pg8::gemm_phase<pg8::Epi<3>, pg8::StaticOrder, true, true>(L, g, S, E);
#endif
 }
      GRID_BAR();
      { PH_VARS
      { const int lane = opq(tid) & 63; post_phase(l, true, x_p, x_s, out, Mo, MOD, post_norm, pre_norm, H, gw, NGW, lane); } }
      GRID_BAR();
    }
    {
      const int l = 2 * li + 1;
      for (int dup_ = 0; dup_ < ((PROBE_DUP & 16) ? 2 : 1); ++dup_) { PH_VARS pg8::EpiP EP{li}; pg8::Gemm g{H, Wb + WO_PIN + (size_t)li * 2048 * 1024, TOK, 2048, 1024, 1024, 0}; pg8::StaticOrder S; S.init(TOK, 2048, G, bx);

#ifndef NO_G1
pg8::Epi<1> E{EP}; pg8::gemm_phase<pg8::Epi<1>, pg8::StaticOrder, true, true>(L, g, S, E);
#endif
 }
      GRID_BAR();
      for (int dup_ = 0; dup_ < ((PROBE_DUP & 256) ? 2 : 1); ++dup_) { PH_VARS
      for (int it = gw; it < TOK / 16 * 4; it += NGW) {
        const int lane = opq(tid) & 63; const int gidx = it & 3, m0 = (it >> 2) * 16 + 8 * (lane >> 5), t0 = m0 & 4095, ch = gidx * 32 + (lane & 31);
        const bf16u* base = U + (size_t)(m0 - t0) * 1024 + 8 * ch; bf16u* dstp = PO + (size_t)m0 * 1024 + 8 * ch;
#define POOL_BODY(HALF) { v4u w[8 + 2 * HALF]; \
          _Pragma("unroll") for (int d = 0; d < 8 + 2 * HALF; ++d) { int tt = t0 - HALF + d; tt = tt < 0 ? 0 : (tt > 4095 ? 4095 : tt); w[d] = *(const v4u*)(base + (size_t)tt * 1024); } \
          float s[8]; _Pragma("unroll") for (int j = 0; j < 8; ++j) s[j] = 0.f; \
          _Pragma("unroll") for (int d = 0; d < 2 * HALF; ++d) { const int tt = t0 - HALF + d; const float f = (tt >= 0 && tt < 4096) ? 1.f : 0.f; \
            _Pragma("unroll") for (int j = 0; j < 4; ++j) { s[2 * j] += f * bflo(w[d][j]); s[2 * j + 1] += f * bfhi(w[d][j]); } } \
          _Pragma("unroll") for (int i = 0; i < 8; ++i) { const int t = t0 + i; const int lo = (t - HALF) < 0 ? 0 : t - HALF, hi2 = (t + HALF) > 4096 ? 4096 : t + HALF; const float rc = 1.f / (float)(hi2 - lo); \
            const v4u uw = w[i + HALF]; v4u o; \
            _Pragma("unroll") for (int j = 0; j < 4; ++j) o[j] = pk2(s[2 * j] * rc - bflo(uw[j]), s[2 * j + 1] * rc - bfhi(uw[j])); \
            *(v4u*)(dstp + (size_t)i * 1024) = o; \
            if (i < 7) { const int ta = t + HALF + 0, tb = t - HALF; const float fa = (ta < 4096) ? 1.f : 0.f, fb = (tb >= 0) ? 1.f : 0.f; \
              _Pragma("unroll") for (int j = 0; j < 4; ++j) { s[2 * j] += fa * bflo(w[i + 2 * HALF][j]) - fb * bflo(w[i][j]); s[2 * j + 1] += fa * bfhi(w[i + 2 * HALF][j]) - fb * bfhi(w[i][j]); } } } }
        if (gidx == 0) POOL_BODY(1) else if (gidx == 1) POOL_BODY(2) else if (gidx == 2) POOL_BODY(4) else POOL_BODY(8)
#undef POOL_BODY
      } }
      GRID_BAR();
      for (int dup_ = 0; dup_ < ((PROBE_DUP & 64) ? 2 : 1); ++dup_) { PH_VARS pg8::EpiP EP{li}; pg8::Gemm g{PO, Wb + WO_GRP + (size_t)li * 262144, TOK, 1024, 256, 1024, 512}; pg8::StaticOrder S; S.init(TOK, 1024, G, bx);

#ifndef NO_G2
pg8::Epi<2> E{EP}; pg8::gemm_phase<pg8::Epi<2>, pg8::StaticOrder, true, true>(L, g, S, E);
#endif
 }
      GRID_BAR();
      for (int dup_ = 0; dup_ < ((PROBE_DUP & 32) ? 2 : 1); ++dup_) { PH_VARS pg8::EpiP EP{li}; pg8::Gemm g{Y, Wb + WO_POUT + (size_t)li * 1024 * 1024, TOK, 1024, 1024, 1024, 0}; pg8::StaticOrder S; S.init(TOK, 1024, G, bx);

#ifndef NO_G3
pg8::Epi<3> E{EP}; pg8::gemm_phase<pg8::Epi<3>, pg8::StaticOrder, true, true>(L, g, S, E);
#endif
 }
      GRID_BAR();
      { PH_VARS
      { const int lane = opq(tid) & 63; post_phase(l, l < 3, x_p, x_s, out, Mo, MOD, post_norm, pre_norm, H, gw, NGW, lane); } }
      if (l < 3) GRID_BAR();
    }
  }
}

extern "C" void kernel_launch(void* const* d_in, const int* in_sizes, int n_in, void* d_out, int out_size, void* d_ws, size_t ws_size, hipStream_t stream) {
  static int grid = 0;
  if (grid == 0) {
    if (n_in != 16 || out_size != TOK * 1024 || ws_size < WS_END) { fprintf(stderr, "kernel_launch: unexpected shapes (n_in %d out %d ws %zu)\n", n_in, out_size, ws_size); grid = -1; return; }
    int dev = 0, cus = 0, per_cu = 0;
    if (hipGetDevice(&dev) != hipSuccess || hipDeviceGetAttribute(&cus, hipDeviceAttributeMultiprocessorCount, dev) != hipSuccess) { grid = -1; return; }
    if (hipFuncSetAttribute((const void*)fwd_mega, hipFuncAttributeMaxDynamicSharedMemorySize, LDS_BYTES) != hipSuccess) { fprintf(stderr, "kernel_launch: hipFuncSetAttribute failed\n"); grid = -1; return; }
    if (hipOccupancyMaxActiveBlocksPerMultiprocessor(&per_cu, (const void*)fwd_mega, 512, LDS_BYTES) != hipSuccess || per_cu < 1) { fprintf(stderr, "kernel_launch: occupancy query %d\n", per_cu); per_cu = 1; }
    (void)hipGetLastError();
    grid = cus * 1;
  }
  if (grid < 0) return;
  (void)hipMemsetAsync((char*)d_ws + WS_MOD, 0, 1 * MiB, stream);
  Args a{};
  for (int i = 0; i < 16; ++i) a.in[i] = (const float*)d_in[i];
  a.out = (float*)d_out; a.ws = (unsigned char*)d_ws;
  for (int j = 0; j < 8; ++j) a.invA[j] = pow(500000.0, -(double)j / 8.0);
  for (int j = 0; j < 16; ++j) a.invX[j] = pow(10000.0, -(double)j / 16.0);
  void* args[] = {&a};
  hipError_t e = hipLaunchCooperativeKernel((const void*)fwd_mega, dim3(grid), dim3(512), args, LDS_BYTES, stream);
  if (e != hipSuccess) fprintf(stderr, "cooperative launch failed: %s (grid %d)\n", hipGetErrorString(e), grid);
}
```
